# Optimizing an MI355X kernel written in HIP

```python
import jax, jax.numpy as jnp
from jax import lax
import numpy as np

D_MODEL = 1024
BATCH = 32
SEQ = 2048
DEPTH = 1

MLA_HEADS = 4
QK_NOPE_DIM = 128
QK_ROPE_DIM = 64
QK_DIM = QK_NOPE_DIM + QK_ROPE_DIM
V_HEAD_DIM = 128
Q_LORA_RANK = 512
KV_LORA_RANK = 256
MLA_WIDTH = MLA_HEADS * V_HEAD_DIM
ROPE_THETA = 10000.0
Q_BLOCK = 128
POOL_WINDOWS = (2, 4, 8, 16)
POOL_GROUPS = len(POOL_WINDOWS)
POOL_WIDTH = D_MODEL - MLA_WIDTH
POOL_GROUP_DIM = POOL_WIDTH // POOL_GROUPS
MIX_WIDTH = MLA_WIDTH + POOL_WIDTH
IN_SPLITS = (Q_LORA_RANK, KV_LORA_RANK, QK_ROPE_DIM, MLA_WIDTH, POOL_WIDTH, POOL_WIDTH)
IN_WIDTH = sum(IN_SPLITS)
RMS_EPS = 1e-6
LN_EPS = 1e-5

kernel_name = "hybrid_mla_multiscale_pool_deepnorm"


def rms_norm(x, g):
    xf = x.astype(jnp.float32)
    inv = lax.rsqrt(jnp.mean(xf * xf, axis=-1, keepdims=True) + RMS_EPS)
    return (xf * inv).astype(x.dtype) * g


def layer_norm(x, g, b):
    xf = x.astype(jnp.float32)
    mu = jnp.mean(xf, axis=-1, keepdims=True)
    var = jnp.mean(jnp.square(xf - mu), axis=-1, keepdims=True)
    return ((xf - mu) * lax.rsqrt(var + LN_EPS)).astype(x.dtype) * g + b


def rope_cos_sin(positions, dtype):
    half = QK_ROPE_DIM // 2
    inv_freq = ROPE_THETA ** (-jnp.arange(half, dtype=jnp.float32) / half)
    ang = positions.astype(jnp.float32)[..., None] * inv_freq
    return jnp.cos(ang).astype(dtype), jnp.sin(ang).astype(dtype)


def apply_rope(t, cos, sin):
    t1, t2 = jnp.split(t, 2, axis=-1)
    return jnp.concatenate([t1 * cos - t2 * sin, t1 * sin + t2 * cos], axis=-1)


def mla_branch(x_q, x_kv, k_rope_raw, positions, q_norm_g, w_uq, kv_norm_g, w_ukv):
    B, S, _ = x_q.shape
    cos, sin = rope_cos_sin(positions, x_q.dtype)
    q = (rms_norm(x_q, q_norm_g) @ w_uq).reshape(B, S, MLA_HEADS, QK_DIM)
    q_nope, q_rope = q[..., :QK_NOPE_DIM], q[..., QK_NOPE_DIM:]
    q_rope = apply_rope(q_rope, cos[:, :, None, :], sin[:, :, None, :])
    kv = (rms_norm(x_kv, kv_norm_g) @ w_ukv).reshape(B, S, MLA_HEADS, QK_NOPE_DIM + V_HEAD_DIM)
    k_nope, v = kv[..., :QK_NOPE_DIM], kv[..., QK_NOPE_DIM:]
    k_rope = apply_rope(k_rope_raw, cos, sin)
    scale = QK_DIM ** -0.5
    nb = S // Q_BLOCK
    qn_b = q_nope.reshape(B, nb, Q_BLOCK, MLA_HEADS, QK_NOPE_DIM).transpose(1, 0, 2, 3, 4)
    qr_b = q_rope.reshape(B, nb, Q_BLOCK, MLA_HEADS, QK_ROPE_DIM).transpose(1, 0, 2, 3, 4)
    pos_b = positions.reshape(B, nb, Q_BLOCK).transpose(1, 0, 2)
    neg = jnp.finfo(jnp.float32).min

    def attend(args):
        qn, qr, pq = args
        s = (jnp.einsum('bqhd,bkhd->bhqk', qn, k_nope)
             + jnp.einsum('bqhr,bkr->bhqk', qr, k_rope)).astype(jnp.float32) * scale
        mask = pq[:, None, :, None] >= positions[:, None, None, :]
        p = jax.nn.softmax(jnp.where(mask, s, neg), axis=-1)
        return jnp.einsum('bhqk,bkhd->bqhd', p.astype(v.dtype), v)

    o = lax.map(attend, (qn_b, qr_b, pos_b))
    return o.transpose(1, 0, 2, 3, 4).reshape(B, S, MLA_WIDTH)


def pool_branch(u, pool_w, pool_scale):
    B, S, _ = u.shape
    uf = u.astype(jnp.float32).reshape(B, S, POOL_GROUPS, POOL_GROUP_DIM)
    cs = jnp.concatenate([jnp.zeros((B, 1, POOL_GROUPS, POOL_GROUP_DIM), jnp.float32),
                          jnp.cumsum(uf, axis=1)], axis=1)
    hi = jnp.arange(S) + 1
    means = []
    for g, w in enumerate(POOL_WINDOWS):
        lo = jnp.maximum(hi - w, 0)
        cnt = (hi - lo).astype(jnp.float32)[None, :, None]
        means.append((cs[:, hi, g] - cs[:, lo, g]) / cnt)
    pooled = jnp.stack(means, axis=2) - uf
    mixed = jnp.einsum('bsgc,gcd->bsgd', pooled.astype(u.dtype), pool_w)
    return mixed.reshape(B, S, POOL_WIDTH) * pool_scale


def setup_inputs(seed: int = 0) -> dict:
    key = jax.random.key(seed)
    ks = jax.random.split(key, 12)
    beta = (8.0 * DEPTH) ** -0.25
    nrm = jax.random.normal
    return {
        "x": nrm(ks[0], (BATCH, SEQ, D_MODEL), jnp.float32),
        "positions": jnp.broadcast_to(jnp.arange(SEQ, dtype=jnp.int32), (BATCH, SEQ)),
        "w_in": nrm(ks[1], (D_MODEL, IN_WIDTH), jnp.float32) * D_MODEL ** -0.5,
        "q_norm_g": 1.0 + 0.05 * nrm(ks[2], (Q_LORA_RANK,), jnp.float32),
        "w_uq": nrm(ks[3], (Q_LORA_RANK, MLA_HEADS * QK_DIM), jnp.float32) * Q_LORA_RANK ** -0.5,
        "kv_norm_g": 1.0 + 0.05 * nrm(ks[4], (KV_LORA_RANK,), jnp.float32),
        "w_ukv": nrm(ks[5], (KV_LORA_RANK, MLA_HEADS * (QK_NOPE_DIM + V_HEAD_DIM)), jnp.float32) * KV_LORA_RANK ** -0.5,
        "pool_w": nrm(ks[6], (POOL_GROUPS, POOL_GROUP_DIM, POOL_GROUP_DIM), jnp.float32) * POOL_GROUP_DIM ** -0.5,
        "pool_scale": 1.0 + 0.1 * nrm(ks[7], (POOL_WIDTH,), jnp.float32),
        "w_out": nrm(ks[8], (MIX_WIDTH, D_MODEL), jnp.float32) * (MIX_WIDTH ** -0.5) * beta,
        "ln_g": 1.0 + 0.05 * nrm(ks[9], (DEPTH, D_MODEL), jnp.float32),
        "ln_b": 0.02 * nrm(ks[10], (DEPTH, D_MODEL), jnp.float32),
    }


def reference(x, positions, w_in, q_norm_g, w_uq, kv_norm_g, w_ukv, pool_w, pool_scale, w_out, ln_g, ln_b):
    alpha = (2.0 * DEPTH) ** 0.25
    splits = [int(c) for c in np.cumsum(IN_SPLITS)[:-1]]
    for layer in range(DEPTH):
        h = x @ w_in
        x_q, x_kv, k_rope_raw, gate_a, u_pool, gate_b = jnp.split(h, splits, axis=-1)
        y_a = mla_branch(x_q, x_kv, k_rope_raw, positions, q_norm_g, w_uq, kv_norm_g, w_ukv) * jax.nn.silu(gate_a)
        y_b = pool_branch(u_pool, pool_w, pool_scale) * jax.nn.silu(gate_b)
        mix = jnp.concatenate([y_a, y_b], axis=-1) @ w_out
        x = layer_norm(alpha * x + mix, ln_g[layer], ln_b[layer])
    return x
```

```cpp
#define MK_N_LAUNCHES 5
#include <hip/hip_runtime.h>
#include <cstdio>
#include <cstdint>
namespace pg8 {
#define PG8_LAS __attribute__((address_space(3)))
typedef unsigned short bf16_t;
typedef short bf16x8 __attribute__((ext_vector_type(8)));
typedef float f32x4 __attribute__((ext_vector_type(4)));
typedef unsigned u32x4 __attribute__((ext_vector_type(4)));
constexpr int BM = 256, BK = 64, HALF = 128, HTB = HALF * BK * 2  , STAGE_BYTES = 8 * HTB, NXCD = 8, WGM = 8;

__host__ __device__ __forceinline__ int lds_byte(int r, int c) { const int st = (r >> 4) * 2 + (c >> 5), rr = r & 15, cc = c & 31, ob = rr * 64 + cc * 2; return st * 1024 + (ob ^ (((ob >> 9) & 1) << 5)); }
__host__ __device__ __forceinline__ void stage_rc(int b, int& R, int& C) { const int st = b / 1024, sb = b % 1024, swz = sb ^ (((sb >> 9) & 1) << 5); R = (st >> 1) * 16 + swz / 64; C = (st & 1) * 32 + (swz % 64) / 2; }
__host__ __device__ __forceinline__ int perm32(int rho) { const int n = rho >> 4, i = rho & 15; return 8 * (i >> 2) + 4 * n + (i & 3); }

struct Unit { int pm, pn; };
struct Gemm { const bf16_t* A; const bf16_t* Bt; int M, N, K; };

struct StaticOrder {
    int nM, nN, nwg, G, c;
    __host__ __device__ void init(int M, int N, int G_, int c_) { nM = M / BM; nN = N / BM; nwg = nM * nN; G = G_; c = c_; }
    __host__ __device__ bool next(int i, Unit& u) const {
        const long L = (long)i * G + c; if (L >= nwg) return false;
        int wgid = (int)L; { const int q = nwg / NXCD, r = nwg % NXCD, xcd = wgid % NXCD, off = wgid / NXCD; wgid = (xcd < r ? xcd * (q + 1) : r * (q + 1) + (xcd - r) * q) + off; }
        const int nig = WGM * nN, gid = wgid / nig, fm = gid * WGM, gsz = (nM - fm) < WGM ? (nM - fm) : WGM;
        u.pm = fm + ((wgid % nig) % gsz); u.pn = (wgid % nig) / gsz; return true;
    }
    __device__ __forceinline__ void a_ready(const Unit&) const {}
    __device__ __forceinline__ void done(const Unit&) const {}
};

__device__ __forceinline__ unsigned cvt_pk_bf16(float lo, float hi) { unsigned r; asm volatile("v_cvt_pk_bf16_f32 %0, %1, %2" : "=v"(r) : "v"(lo), "v"(hi)); return r; }
__device__ __forceinline__ float silu_f(float x) { return x * __builtin_amdgcn_rcpf(1.0f + __builtin_amdgcn_exp2f(-1.4426950408889634f * x)); }
__device__ __forceinline__ void sincos_rad(float ang, float& s, float& c) {
    const float I2PI_HI = 0.15915494f, I2PI_LO = 6.4206383e-9f;
    const float k = __builtin_rintf(ang * I2PI_HI);
    float r = __builtin_fmaf(ang, I2PI_HI, -k);
    r = __builtin_fmaf(ang, I2PI_LO, r);
    s = __builtin_amdgcn_sinf(r); c = __builtin_amdgcn_cosf(r);
}
__device__ __forceinline__ float rope_inv_freq(int j) { return exp2f(-(float)j * 0.41524101186092029f); }
typedef float f32x2_t __attribute__((ext_vector_type(2))); typedef __bf16 bf16x2_t __attribute__((ext_vector_type(2)));
__device__ __forceinline__ unsigned cvtpk_c(float lo, float hi) { f32x2_t v = {lo, hi}; bf16x2_t b = __builtin_convertvector(v, bf16x2_t); return __builtin_bit_cast(unsigned, b); }
__device__ __forceinline__ u32x4 pack8f(const f32x4 a, const f32x4 b) { u32x4 w; w.x = cvtpk_c(a[0], a[1]); w.y = cvtpk_c(a[2], a[3]); w.z = cvtpk_c(b[0], b[1]); w.w = cvtpk_c(b[2], b[3]); return w; }

struct EpiP1 {
    static constexpr bool PERM = true, AFTER_DRAIN = false;
    bf16_t *XQ, *XKV, *GA, *U, *GB, *KR; float *SSQ, *SSKV; const int* pos;
    __device__ __forceinline__ void operator()(const f32x4 (&acc)[2][2][4][2], const Unit& u, int wr, int wc, int fr, int fq) const {
        const int row0 = u.pm * BM + wr * 64 + fr; const int pn = u.pn;
        if (pn == 9) {
            if (wc < 2) {
                float fqv[4];
#pragma unroll
                for (int i = 0; i < 4; ++i) fqv[i] = rope_inv_freq(16 * wc + 4 * fq + i);
#pragma unroll
                for (int ai = 0; ai < 2; ++ai)
#pragma unroll
                    for (int m = 0; m < 4; ++m) { const int row = row0 + ai * HALF + m * 16; const float pf = (float)pos[row];
                        const f32x4 t1 = acc[ai][0][m][0], t2 = acc[ai][0][m][1]; f32x4 o1, o2;
#pragma unroll
                        for (int i = 0; i < 4; ++i) { float s, c; sincos_rad(pf * fqv[i], s, c); o1[i] = t1[i] * c - t2[i] * s; o2[i] = t1[i] * s + t2[i] * c; }
                        *(u32x4*)(KR + (size_t)row * 64 + 32 * wc + 8 * fq) = pack8f(o1, o2); }
            }
            return;
        }
        bf16_t* dst; int ld, colt; bool act = false; float* ss = nullptr; int nparts = 0, part = 0;
        if (pn < 2) { dst = XQ; ld = 512; colt = pn * 256; ss = SSQ; nparts = 8; part = pn * 4 + wc; }
        else if (pn == 2) { dst = XKV; ld = 256; colt = 0; ss = SSKV; nparts = 4; part = wc; }
        else if (pn < 5) { dst = GA; ld = 512; colt = (pn - 3) * 256; act = true; }
        else if (pn < 7) { dst = U; ld = 512; colt = (pn - 5) * 256; }
        else { dst = GB; ld = 512; colt = (pn - 7) * 256; act = true; }
        const int col0 = colt + wc * 32 + 8 * fq;
#pragma unroll
        for (int ai = 0; ai < 2; ++ai)
#pragma unroll
            for (int m = 0; m < 4; ++m) { const int row = row0 + ai * HALF + m * 16; bf16_t* rowp = dst + (size_t)row * ld + col0; float sq = 0.f;
#pragma unroll
                for (int bj = 0; bj < 2; ++bj) { f32x4 v0 = acc[ai][bj][m][0], v1 = acc[ai][bj][m][1];
                    if (act) {
#pragma unroll
                        for (int i = 0; i < 4; ++i) { v0[i] = silu_f(v0[i]); v1[i] = silu_f(v1[i]); } }
                    sq += (v0[0] * v0[0] + v0[1] * v0[1]) + (v0[2] * v0[2] + v0[3] * v0[3]) + (v1[0] * v1[0] + v1[1] * v1[1]) + (v1[2] * v1[2] + v1[3] * v1[3]);
                    *(u32x4*)(rowp + bj * HALF) = pack8f(v0, v1); }
                if (ss) { sq += __shfl_xor(sq, 16); sq += __shfl_xor(sq, 32); if (fq == 0) ss[(size_t)row * nparts + part] = sq; } }
    }
};

constexpr float QSCALE = 0.07216878364870323f * 1.4426950408889634f;
struct EpiQ {
    static constexpr bool PERM = true, AFTER_DRAIN = false;
    bf16_t* Q; const float* SSQ; const int* pos;
    __device__ __forceinline__ void operator()(const f32x4 (&acc)[2][2][4][2], const Unit& u, int wr, int wc, int fr, int fq) const {
        const int row0 = u.pm * BM + wr * 64 + fr; const int pn = u.pn;
        float fqv[4];
#pragma unroll
        for (int i = 0; i < 4; ++i) fqv[i] = rope_inv_freq(16 * (wc & 1) + 4 * fq + i);
#pragma unroll
        for (int ai = 0; ai < 2; ++ai)
#pragma unroll
            for (int m = 0; m < 4; ++m) { const int row = row0 + ai * HALF + m * 16;
                const f32x4 s0 = *(const f32x4*)(SSQ + (size_t)row * 8), s1 = *(const f32x4*)(SSQ + (size_t)row * 8 + 4);
                const float ssum = ((s0[0] + s0[1]) + (s0[2] + s0[3])) + ((s1[0] + s1[1]) + (s1[2] + s1[3]));
                const float rinv = __builtin_amdgcn_rsqf(ssum * (1.0f / 512.0f) + 1e-6f) * QSCALE;
                bf16_t* qrow = Q + (size_t)row * 768;
                if (pn < 2) {
#pragma unroll
                    for (int bj = 0; bj < 2; ++bj) *(u32x4*)(qrow + (2 * pn + bj) * 192 + 32 * wc + 8 * fq) = pack8f(acc[ai][bj][m][0] * rinv, acc[ai][bj][m][1] * rinv);
                } else { const float pf = (float)pos[row];
                    float sn[4], cs[4];
#pragma unroll
                    for (int i = 0; i < 4; ++i) sincos_rad(pf * fqv[i], sn[i], cs[i]);
#pragma unroll
                    for (int bj = 0; bj < 2; ++bj) { const f32x4 t1 = acc[ai][bj][m][0] * rinv, t2 = acc[ai][bj][m][1] * rinv; f32x4 o1, o2;
#pragma unroll
                        for (int i = 0; i < 4; ++i) { o1[i] = t1[i] * cs[i] - t2[i] * sn[i]; o2[i] = t1[i] * sn[i] + t2[i] * cs[i]; }
                        *(u32x4*)(qrow + (2 * bj + (wc >> 1)) * 192 + 128 + 32 * (wc & 1) + 8 * fq) = pack8f(o1, o2); } } }
    }
};
struct EpiKV {
    static constexpr bool PERM = true, AFTER_DRAIN = false;
    bf16_t *KN, *VV; const float* SSKV;
    __device__ __forceinline__ void operator()(const f32x4 (&acc)[2][2][4][2], const Unit& u, int wr, int wc, int fr, int fq) const {
        const int row0 = u.pm * BM + wr * 64 + fr; const int pn = u.pn;
#pragma unroll
        for (int ai = 0; ai < 2; ++ai)
#pragma unroll
            for (int m = 0; m < 4; ++m) { const int row = row0 + ai * HALF + m * 16;
                const f32x4 s0 = *(const f32x4*)(SSKV + (size_t)row * 4);
                const float rinv = __builtin_amdgcn_rsqf(((s0[0] + s0[1]) + (s0[2] + s0[3])) * (1.0f / 256.0f) + 1e-6f);
                const size_t o = (size_t)row * 512 + pn * 128 + 32 * wc + 8 * fq;
                *(u32x4*)(KN + o) = pack8f(acc[ai][0][m][0] * rinv, acc[ai][0][m][1] * rinv);
                *(u32x4*)(VV + o) = pack8f(acc[ai][1][m][0] * rinv, acc[ai][1][m][1] * rinv); }
    }
};
struct EpiOutZ {
    static constexpr bool PERM = false, AFTER_DRAIN = false;
    static constexpr float alpha = 1.189207115002721f;
    const float* x; float* out; PG8_LAS float* rst;
    __device__ __forceinline__ void operator()(const f32x4 (&acc)[2][2][4][2], const Unit& u, int wr, int wc, int fr, int fq) const {
        const __amdgpu_buffer_rsrc_t rX = __builtin_amdgcn_make_buffer_rsrc((void*)x, 0, 65536u * 1024u * 4u, 0x00020000), rO = __builtin_amdgcn_make_buffer_rsrc((void*)out, 0, 65536u * 1024u * 4u, 0x00020000);
        const int vo = (fr * 1024 + wc * 32 + 4 * fq) * 4;
        const int so0 = ((u.pm * BM + wr * 64) * 1024 + u.pn * BM) * 4;
#pragma unroll
        for (int ai = 0; ai < 2; ++ai)
#pragma unroll
            for (int m = 0; m < 4; ++m) { const int so = so0 + (ai * HALF + m * 16) * 4096; f32x4 z[2][2]; float s = 0.f, q = 0.f;
#pragma unroll
                for (int bj = 0; bj < 2; ++bj)
#pragma unroll
                    for (int n = 0; n < 2; ++n) { const f32x4 xv = __builtin_bit_cast(f32x4, __builtin_amdgcn_raw_buffer_load_b128(rX, vo + (bj * HALF + n * 16) * 4, so, 0)); z[bj][n] = acc[ai][bj][m][n] + xv * alpha; }
#pragma unroll
                for (int bj = 0; bj < 2; ++bj)
#pragma unroll
                    for (int n = 0; n < 2; ++n) { const f32x4 v = z[bj][n]; s += (v[0] + v[1]) + (v[2] + v[3]); q += (v[0] * v[0] + v[1] * v[1]) + (v[2] * v[2] + v[3] * v[3]);
                        __builtin_amdgcn_raw_buffer_store_b128(__builtin_bit_cast(u32x4, v), rO, vo + (bj * HALF + n * 16) * 4, so, 0); }
                s += __shfl_xor(s, 16); s += __shfl_xor(s, 32); q += __shfl_xor(q, 16); q += __shfl_xor(q, 32);
                if (fq == 0) { PG8_LAS float* p = rst + ((wc * 256) + ai * HALF + wr * 64 + m * 16 + fr) * 2; p[0] += s; p[1] += q; } }
    }
};
struct PanelOrder {
    int nN, pm;
    __device__ __forceinline__ bool next(int i, Unit& u) const { if (i >= nN) return false; u.pm = pm; u.pn = i; return true; }
    __device__ __forceinline__ void a_ready(const Unit&) const {}
    __device__ __forceinline__ void done(const Unit&) const {}
};
template <class Epi, class Sched, bool ALIGN_EPI = false, bool SP2 = false>
__device__ __forceinline__ void gemm_phase(PG8_LAS unsigned char* lds, const Gemm g, const Sched& S, const Epi& E) {
    const int tid = threadIdx.x, wid = __builtin_amdgcn_readfirstlane(tid >> 6), lane = tid & 63, wr = wid >> 2, wc = wid & 3, fr = lane & 15, fq = lane >> 4;
    const int K = g.K, nt = K / BK;
    unsigned voffA[2], voffB[2];
#pragma unroll
    for (int i = 0; i < 2; ++i) { int R, C; stage_rc(tid * 16 + i * 8192, R, C); const int Rb = Epi::PERM ? ((R & ~31) + perm32(R & 31)) : R;
        voffA[i] = (unsigned)(R * K + C) * 2u; voffB[i] = (unsigned)(Rb * K + C) * 2u; }
    const size_t kstep = (size_t)(BK * 2);
    const size_t hstep = (size_t)HALF * K * 2;
    const size_t tstep = 2 * hstep;
    const unsigned ldsw = (unsigned)wid * 1024u;
    const int aoff = lds_byte(wr * 64 + fr, fq * 8), boff = lds_byte(wc * 32 + fr, fq * 8);
#define PG8_SA(b, h) (((b) * 2 + (h)) * HTB)
#define PG8_SB(b, h) ((4 + (b) * 2 + (h)) * HTB)
#define PG8_STAGE(bufoff, gbase, voff) do { _Pragma("unroll") for (int _i = 0; _i < 2; ++_i) \
        __builtin_amdgcn_global_load_lds((const unsigned*)((const char*)(gbase) + (voff)[_i]), (PG8_LAS unsigned*)(lds + (bufoff) + ldsw + _i * 8192), 16, 0, 0); } while (0)
#define PG8_LDA(dst, b, h) do { _Pragma("unroll") for (int m = 0; m < 4; ++m) _Pragma("unroll") for (int k = 0; k < 2; ++k) dst[m][k] = *(const PG8_LAS bf16x8*)(lds + PG8_SA(b, h) + aoff + m * 2048 + k * 1024); } while (0)
#define PG8_LDB(dst, b, h) do { _Pragma("unroll") for (int n = 0; n < 2; ++n) _Pragma("unroll") for (int k = 0; k < 2; ++k) dst[n][k] = *(const PG8_LAS bf16x8*)(lds + PG8_SB(b, h) + boff + n * 2048 + k * 1024); } while (0)
#define PG8_MMA(ai, bj, At, Bt) do { __builtin_amdgcn_s_setprio(1); _Pragma("unroll") for (int m = 0; m < 4; ++m) _Pragma("unroll") for (int n = 0; n < 2; ++n) _Pragma("unroll") for (int k = 0; k < 2; ++k) \
        acc[ai][bj][m][n] = __builtin_amdgcn_mfma_f32_16x16x32_bf16(Bt[n][k], At[m][k], acc[ai][bj][m][n], 0, 0, 0); __builtin_amdgcn_s_setprio(0); } while (0)
#define PG8_WAIT_V(n) asm volatile("s_waitcnt vmcnt(" #n ")" ::: "memory")
#define PG8_WAIT_L(n) asm volatile("s_waitcnt lgkmcnt(" #n ")" ::: "memory")
#define PG8_BAR __builtin_amdgcn_s_barrier()
#define PG8_SCHED __builtin_amdgcn_sched_barrier(0)
    Unit cur, nxt; int ui = 0;
    if (!S.next(0, cur)) return;
    f32x4 acc[2][2][4][2];
#pragma unroll
    for (int a = 0; a < 2; ++a)
#pragma unroll
        for (int b = 0; b < 2; ++b)
#pragma unroll
            for (int m = 0; m < 4; ++m)
#pragma unroll
                for (int n = 0; n < 2; ++n) acc[a][b][m][n] = (f32x4){0.f, 0.f, 0.f, 0.f};
    bf16x8 At[4][2], B0[2][2], B1[2][2];
    const char* cA = (const char*)g.A + (size_t)cur.pm * tstep; const char* cB = (const char*)g.Bt + (size_t)cur.pn * tstep;
    S.a_ready(cur);
    if constexpr (SP2) {
        PG8_STAGE(PG8_SB(0, 0), cB, voffB); PG8_STAGE(PG8_SB(0, 1), cB + hstep, voffB); PG8_STAGE(PG8_SA(0, 0), cA, voffA); PG8_STAGE(PG8_SA(0, 1), cA + hstep, voffA);
        if (wr == 1) PG8_BAR;
        PG8_WAIT_V(2); PG8_BAR;
        PG8_STAGE(PG8_SB(1, 0), cB + kstep, voffB); PG8_STAGE(PG8_SA(1, 0), cA + kstep, voffA); PG8_STAGE(PG8_SB(1, 1), cB + hstep + kstep, voffB);
        PG8_WAIT_V(6); PG8_BAR;
    } else {
        PG8_STAGE(PG8_SB(0, 0), cB, voffB); PG8_STAGE(PG8_SA(0, 0), cA, voffA); PG8_STAGE(PG8_SB(0, 1), cB + hstep, voffB); PG8_STAGE(PG8_SA(0, 1), cA + hstep, voffA);
        if (wr == 1) PG8_BAR;
        PG8_WAIT_V(4); PG8_BAR;
        PG8_STAGE(PG8_SB(1, 0), cB + kstep, voffB); PG8_STAGE(PG8_SA(1, 0), cA + kstep, voffA); PG8_STAGE(PG8_SB(1, 1), cB + hstep + kstep, voffB);
        PG8_WAIT_V(6); PG8_BAR;
    }
    for (;;) {
        const bool has_next = S.next(ui + 1, nxt);
        const char* nA = has_next ? (const char*)g.A + (size_t)nxt.pm * tstep : cA; const char* nB = has_next ? (const char*)g.Bt + (size_t)nxt.pn * tstep : cB;
        for (int t = 0; t < nt; t += 2) {
            const bool last = (t == nt - 2);
            const char* a1 = cA + (size_t)(t + 1) * kstep;
            const char* a2 = last ? nA : cA + (size_t)(t + 2) * kstep; const char* b2 = last ? nB : cB + (size_t)(t + 2) * kstep;
            const char* a3 = a2 + kstep; const char* b3 = b2 + kstep;
            if (last && has_next) S.a_ready(nxt);
            if constexpr (SP2) {
            PG8_LDB(B0, 0, 0); PG8_LDB(B1, 0, 1); PG8_SCHED; PG8_LDA(At, 0, 0); PG8_STAGE(PG8_SA(1, 1), a1 + hstep, voffA);
            PG8_WAIT_V(8); PG8_WAIT_L(0); PG8_BAR; PG8_MMA(0, 0, At, B0); PG8_MMA(0, 1, At, B1); PG8_BAR; PG8_SCHED;
            PG8_LDA(At, 0, 1); PG8_STAGE(PG8_SB(0, 0), b2, voffB); PG8_STAGE(PG8_SB(0, 1), b2 + hstep, voffB); PG8_STAGE(PG8_SA(0, 0), a2, voffA);
            PG8_WAIT_V(8); PG8_WAIT_L(0); PG8_BAR; PG8_MMA(1, 0, At, B0); PG8_MMA(1, 1, At, B1); PG8_BAR; PG8_SCHED;
            PG8_LDB(B0, 1, 0); PG8_LDB(B1, 1, 1); PG8_SCHED; PG8_LDA(At, 1, 0); PG8_STAGE(PG8_SA(0, 1), a2 + hstep, voffA);
            PG8_WAIT_V(8); PG8_WAIT_L(0); PG8_BAR; PG8_MMA(0, 0, At, B0); PG8_MMA(0, 1, At, B1); PG8_BAR; PG8_SCHED;
            PG8_LDA(At, 1, 1); PG8_STAGE(PG8_SB(1, 0), b3, voffB); PG8_STAGE(PG8_SB(1, 1), b3 + hstep, voffB); PG8_STAGE(PG8_SA(1, 0), a3, voffA);
            PG8_WAIT_V(8); PG8_WAIT_L(0); PG8_BAR; PG8_MMA(1, 0, At, B0); PG8_MMA(1, 1, At, B1); PG8_BAR; PG8_SCHED;
            } else {
            PG8_LDB(B0, 0, 0); PG8_SCHED; PG8_LDA(At, 0, 0); PG8_STAGE(PG8_SA(1, 1), a1 + hstep, voffA);
            PG8_WAIT_L(8); PG8_BAR; PG8_WAIT_L(0); PG8_MMA(0, 0, At, B0); PG8_BAR; PG8_SCHED;
            PG8_LDB(B1, 0, 1); PG8_STAGE(PG8_SB(0, 0), b2, voffB);
            PG8_BAR; PG8_WAIT_L(0); PG8_MMA(0, 1, At, B1); PG8_BAR;
            PG8_LDA(At, 0, 1); PG8_STAGE(PG8_SA(0, 0), a2, voffA);
            PG8_BAR; PG8_WAIT_L(0); PG8_MMA(1, 0, At, B0); PG8_BAR; PG8_SCHED;
            PG8_STAGE(PG8_SB(0, 1), b2 + hstep, voffB);
            PG8_WAIT_V(6); PG8_BAR; PG8_MMA(1, 1, At, B1); PG8_BAR;
            PG8_LDB(B0, 1, 0); PG8_SCHED; PG8_LDA(At, 1, 0); PG8_STAGE(PG8_SA(0, 1), a2 + hstep, voffA);
            PG8_WAIT_L(8); PG8_BAR; PG8_WAIT_L(0); PG8_MMA(0, 0, At, B0); PG8_BAR; PG8_SCHED;
            PG8_LDB(B1, 1, 1); PG8_STAGE(PG8_SB(1, 0), b3, voffB);
            PG8_BAR; PG8_WAIT_L(0); PG8_MMA(0, 1, At, B1); PG8_BAR;
            PG8_LDA(At, 1, 1); PG8_STAGE(PG8_SA(1, 0), a3, voffA);
            PG8_BAR; PG8_WAIT_L(0); PG8_MMA(1, 0, At, B0); PG8_BAR; PG8_SCHED;
            PG8_STAGE(PG8_SB(1, 1), b3 + hstep, voffB);
            PG8_WAIT_V(6); PG8_BAR; PG8_MMA(1, 1, At, B1); PG8_BAR;
            }
        }
        if constexpr (ALIGN_EPI) { if (wr == 0) PG8_BAR; }
        if constexpr (!Epi::AFTER_DRAIN) { E(acc, cur, wr, wc, fr, fq); S.done(cur); }
        if (!has_next) break;
#pragma unroll
        for (int a = 0; a < 2; ++a)
#pragma unroll
            for (int b = 0; b < 2; ++b)
#pragma unroll
                for (int m = 0; m < 4; ++m)
#pragma unroll
                    for (int n = 0; n < 2; ++n) acc[a][b][m][n] = (f32x4){0.f, 0.f, 0.f, 0.f};
        cur = nxt; cA = nA; cB = nB; ++ui;
        if constexpr (ALIGN_EPI) { if (wr == 1) PG8_BAR; }
    }
    PG8_WAIT_V(0);
    if constexpr (!ALIGN_EPI) { if (wr == 0) PG8_BAR; }
    PG8_BAR;
    if constexpr (Epi::AFTER_DRAIN) { E.fused(acc, cur, wr, wc, fr, fq, lds, wid, lane); S.done(cur); }
#undef PG8_SA
#undef PG8_SB
#undef PG8_STAGE
#undef PG8_LDA
#undef PG8_LDB
#undef PG8_MMA
#undef PG8_WAIT_V
#undef PG8_WAIT_L
#undef PG8_BAR
#undef PG8_SCHED
}
}
#ifndef PG8_SP2
#define PG8_SP2 true
#endif
#ifndef PG8_ALIGN
#define PG8_ALIGN true
#endif
namespace attn {
#define ATT_LAS __attribute__((address_space(3)))
typedef unsigned short bf16_t;
typedef short bf16x8 __attribute__((ext_vector_type(8)));
typedef short s16x4 __attribute__((ext_vector_type(4)));
typedef float f32x16 __attribute__((ext_vector_type(16)));
typedef float f32x4 __attribute__((ext_vector_type(4)));
typedef unsigned u32x4 __attribute__((ext_vector_type(4)));
typedef int i32x4 __attribute__((ext_vector_type(4)));
typedef ATT_LAS char* lptr;
constexpr int NW = 8, QBLK = 32, QB = 256, KVBLK = 64, SEQ = 2048;
constexpr int SHM_V = 16384, KROW = 400, SHM_K = 64 * KROW, QRROW = 272, SHM_QR = 32 * QRROW, NQREG = 4;
constexpr int LDS_V = 0, LDS_K = 2 * SHM_V, LDS_QR = LDS_K + 2 * SHM_K, LDS_WS = LDS_QR + NW * SHM_QR, LDS_BYTES = LDS_WS + NW * 256;
constexpr float THR = 8.f;
#define SBAR() __builtin_amdgcn_sched_barrier(0)
__device__ __forceinline__ int v_st(int k, int c) { const int kk = (k & ~0xC) | ((k & 4) << 1) | ((k & 8) >> 1); return ((kk >> 3) * 4 + (c >> 5)) * 512 + ((kk & 7) * 32 + (c & 31)) * 2; }
__device__ __forceinline__ int v_rd_base(int lane) { return ((lane & 3) << 3) | (((lane >> 2) & 3) << 6) | (((lane >> 4) & 1) << 5) | (((lane >> 5) & 1) << 8); }
constexpr int v_rd_off(int d0, int ks, int half) { return d0 * 512 + ks * 4096 + half * 2048; }
__device__ __forceinline__ int crow(int r, int hi) { return (r & 3) + 8 * (r >> 2) + 4 * hi; }
typedef float f32x2_t __attribute__((ext_vector_type(2))); typedef __bf16 bf16x2_t __attribute__((ext_vector_type(2)));
__device__ __forceinline__ unsigned cvtpk(float lo, float hi) { f32x2_t v = {lo, hi}; bf16x2_t b = __builtin_convertvector(v, bf16x2_t); return __builtin_bit_cast(unsigned, b); }
typedef short v4i16_t __attribute__((ext_vector_type(4)));
__device__ __forceinline__ s16x4 vtr(lptr p) { return __builtin_bit_cast(s16x4, __builtin_amdgcn_ds_read_tr16_b64_v4i16((ATT_LAS v4i16_t*)p)); }

__device__ __forceinline__ void partialSM(f32x16& p0, f32x16& p1, float& m_reg, float& alpha) {
    float pmax = p0[0];
#pragma unroll
    for (int r = 1; r < 16; ++r) pmax = fmaxf(pmax, p0[r]);
#pragma unroll
    for (int r = 0; r < 16; ++r) pmax = fmaxf(pmax, p1[r]);
    { auto rr = __builtin_amdgcn_permlane32_swap(__float_as_uint(pmax), __float_as_uint(pmax), false, false);
      pmax = fmaxf(__uint_as_float(rr[0]), __uint_as_float(rr[1])); }
    float mn;
    if (__builtin_expect(__all((pmax - m_reg) <= THR), 1)) { mn = m_reg; alpha = 1.f; }
    else { mn = fmaxf(m_reg, pmax); alpha = __builtin_amdgcn_exp2f(m_reg - mn); m_reg = mn; }
#pragma unroll
    for (int r = 0; r < 16; ++r) { p0[r] -= mn; p1[r] -= mn; }
#pragma unroll
    for (int r = 0; r < 16; ++r) p0[r] = __builtin_amdgcn_exp2f(p0[r]);
}
__device__ __forceinline__ void finishSM(f32x16& p0, f32x16& p1, float alpha, float& l_reg, bf16x8& pa0, bf16x8& pa1, bf16x8& pa2, bf16x8& pa3) {
#pragma unroll
    for (int r = 0; r < 16; ++r) p1[r] = __builtin_amdgcn_exp2f(p1[r]);
    float ps = 0.f;
#pragma unroll
    for (int r = 0; r < 16; ++r) ps += p0[r];
#pragma unroll
    for (int r = 0; r < 16; ++r) ps += p1[r];
    { auto rr = __builtin_amdgcn_permlane32_swap(__float_as_uint(ps), __float_as_uint(ps), false, false);
      ps = __uint_as_float(rr[0]) + __uint_as_float(rr[1]); }
    l_reg = l_reg * alpha + ps;
#define PK4(P, B_, OUT) do { unsigned a0 = cvtpk(P[B_+0], P[B_+1]), a1 = cvtpk(P[B_+2], P[B_+3]);                          \
        unsigned b0 = cvtpk(P[B_+4], P[B_+5]), b1 = cvtpk(P[B_+6], P[B_+7]);                                             \
        auto r0 = __builtin_amdgcn_permlane32_swap(a0, b0, false, false); auto r1 = __builtin_amdgcn_permlane32_swap(a1, b1, false, false); \
        u32x4 w = {r0[0], r1[0], r0[1], r1[1]}; OUT = __builtin_bit_cast(bf16x8, w); } while (0)
    PK4(p0, 0, pa0); PK4(p0, 8, pa1); PK4(p1, 0, pa2); PK4(p1, 8, pa3);
#undef PK4
}
template <int KB>
__device__ __forceinline__ void qkt(f32x16& p0, f32x16& p1, lptr kbase, lptr qrb, const bf16x8* qr) {
    p0 = f32x16{}; p1 = f32x16{};
    lptr a = kbase + KB * SHM_K;
#pragma unroll
    for (int d0 = 0; d0 < 12; ++d0) {
        const bf16x8 b0 = *(const ATT_LAS bf16x8*)(a + d0 * 32);
        const bf16x8 b1 = *(const ATT_LAS bf16x8*)(a + d0 * 32 + 32 * KROW);
        bf16x8 q; if (d0 < NQREG) q = qr[d0]; else q = *(const ATT_LAS bf16x8*)(qrb + (d0 - NQREG) * 32);
        p0 = __builtin_amdgcn_mfma_f32_32x32x16_bf16(b0, q, p0, 0, 0, 0);
        p1 = __builtin_amdgcn_mfma_f32_32x32x16_bf16(b1, q, p1, 0, 0, 0);
    }
}
template <int VB>
__device__ __forceinline__ void pv_tile(f32x16* o, lptr vb0, bf16x8 pa0, bf16x8 pa1, bf16x8 pa2, bf16x8 pa3) {
#define PV_D0(d0) do { lptr b_ = vb0 + VB * SHM_V + v_rd_off(d0, 0, 0);     \
        const s16x4 l0 = vtr(b_), h0 = vtr(b_ + 2048), l1 = vtr(b_ + 4096), h1 = vtr(b_ + 6144), l2 = vtr(b_ + 8192), h2 = vtr(b_ + 10240), l3 = vtr(b_ + 12288), h3 = vtr(b_ + 14336); \
        o[d0] = __builtin_amdgcn_mfma_f32_32x32x16_bf16(pa0, (bf16x8){l0[0], l0[1], l0[2], l0[3], h0[0], h0[1], h0[2], h0[3]}, o[d0], 0, 0, 0);   \
        o[d0] = __builtin_amdgcn_mfma_f32_32x32x16_bf16(pa1, (bf16x8){l1[0], l1[1], l1[2], l1[3], h1[0], h1[1], h1[2], h1[3]}, o[d0], 0, 0, 0);   \
        o[d0] = __builtin_amdgcn_mfma_f32_32x32x16_bf16(pa2, (bf16x8){l2[0], l2[1], l2[2], l2[3], h2[0], h2[1], h2[2], h2[3]}, o[d0], 0, 0, 0);   \
        o[d0] = __builtin_amdgcn_mfma_f32_32x32x16_bf16(pa3, (bf16x8){l3[0], l3[1], l3[2], l3[3], h3[0], h3[1], h3[2], h3[3]}, o[d0], 0, 0, 0); } while (0)
    PV_D0(0); PV_D0(1); PV_D0(2); PV_D0(3);
#undef PV_D0
}
__device__ __forceinline__ unsigned mul_bf16x2(unsigned a, unsigned g) {
    const float al = __uint_as_float(a << 16), ah = __uint_as_float(a & 0xffff0000u), gl = __uint_as_float(g << 16), gh = __uint_as_float(g & 0xffff0000u);
    return cvtpk(al * gl, ah * gh);
}
struct Tensors { const bf16_t *Q, *KN, *KR, *VV, *GA; bf16_t* Y; const int *pos, *pmin, *pmax, *hmin; };
typedef __amdgpu_buffer_rsrc_t rsrc_t;
__device__ __forceinline__ rsrc_t mkrsrc(const void* p, unsigned bytes) { return __builtin_amdgcn_make_buffer_rsrc((void*)p, 0, bytes, 0x00020000); }
__device__ __forceinline__ bf16x8 bload(rsrc_t r, int voff, int soff) { return __builtin_bit_cast(bf16x8, __builtin_amdgcn_raw_buffer_load_b128(r, voff, soff, 0)); }
__device__ __forceinline__ void mask_tile_pos(f32x16& p0, f32x16& p1, int pq, rsrc_t rP, int pvo, int pso) {
    const float NEG = -__builtin_inff();
#pragma unroll
    for (int g = 0; g < 4; ++g) { const i32x4 a = __builtin_bit_cast(i32x4, __builtin_amdgcn_raw_buffer_load_b128(rP, pvo + 32 * g, pso, 0)), b = __builtin_bit_cast(i32x4, __builtin_amdgcn_raw_buffer_load_b128(rP, pvo + 128 + 32 * g, pso, 0));
#pragma unroll
        for (int i = 0; i < 4; ++i) { if (pq < a[i]) p0[4 * g + i] = NEG; if (pq < b[i]) p1[4 * g + i] = NEG; }
        asm volatile("" ::: "memory"); }
}
__device__ __forceinline__ void attn_unit(int b, int h, int qb, const Tensors& T, lptr lds) {
    const int tid = threadIdx.x, wid = __builtin_amdgcn_readfirstlane(tid >> 6), lane = tid & 63, r32 = lane & 31, hi = lane >> 5;
    const int rowbase = b * SEQ, q0 = qb * QB;
    constexpr unsigned MTOK = 65536u;
    const rsrc_t rQ = mkrsrc(T.Q, MTOK * 768u * 2u), rKN = mkrsrc(T.KN, MTOK * 512u * 2u), rKR = mkrsrc(T.KR, MTOK * 64u * 2u), rVV = mkrsrc(T.VV, MTOK * 512u * 2u),
                 rGA = mkrsrc(T.GA, MTOK * 512u * 2u), rY = mkrsrc(T.Y, MTOK * 1024u * 2u), rP = mkrsrc(T.pos, MTOK * 4u);
    int NT;
    { const int* pmx = T.pmax + b * 32 + 4 * qb; const int qmax = max(max(pmx[0], pmx[1]), max(pmx[2], pmx[3]));
      const int pml = T.pmin[b * 32 + (lane & 31)];
      const unsigned m32 = (unsigned)__ballot(pml <= qmax);
      NT = m32 ? 32 - __clz(m32) : 1; NT = __builtin_amdgcn_readfirstlane(NT); }
    const int qminw = __builtin_amdgcn_readfirstlane(T.hmin[b * 64 + qb * 8 + wid]);
    const int pq = __builtin_amdgcn_raw_buffer_load_b32(rP, r32 * 4, (rowbase + q0 + wid * QBLK) * 4, 0);
    lptr V_lds = lds + LDS_V; lptr K_lds = lds + LDS_K; lptr QRw = lds + LDS_QR + wid * SHM_QR;
    ATT_LAS float* ws = (ATT_LAS float*)(lds + LDS_WS) + wid * 64; ATT_LAS float* li_l = ws; ATT_LAS float* al_l = ws + 32;
    const int sr = tid >> 4, sc = tid & 15, rr = tid >> 3, rc = tid & 7;
    const int kw0 = sr * KROW + sc * 16, kw2 = rr * KROW + 256 + rc * 16;
    const int vst0 = v_st(sr, sc * 8); constexpr int vst1d = 8192;
    const int kv_vo = (sr * 512 + sc * 8) * 2, kr_vo = (rr * 64 + rc * 8) * 2;
    const int kv_s0 = (rowbase * 512 + h * 128) * 2, kr_s0 = rowbase * 64 * 2;
    bf16x8 st_k0, st_k1, st_k2, st_v0, st_v1;
#define VMW() asm volatile("s_waitcnt vmcnt(0)" ::: "memory")
#define SLOAD(t) do { const int so_ = kv_s0 + (t) * 65536; st_v0 = bload(rVV, kv_vo, so_); st_v1 = bload(rVV, kv_vo, so_ + 32768); \
        st_k0 = bload(rKN, kv_vo, so_); st_k1 = bload(rKN, kv_vo, so_ + 32768); st_k2 = bload(rKR, kr_vo, kr_s0 + (t) * 8192); } while (0)
#define SWRITE(bf) do { *(ATT_LAS bf16x8*)(V_lds + (bf) * SHM_V + vst0) = st_v0; *(ATT_LAS bf16x8*)(V_lds + (bf) * SHM_V + vst0 + vst1d) = st_v1; \
        *(ATT_LAS bf16x8*)(K_lds + (bf) * SHM_K + kw0) = st_k0; *(ATT_LAS bf16x8*)(K_lds + (bf) * SHM_K + kw0 + 32 * KROW) = st_k1; *(ATT_LAS bf16x8*)(K_lds + (bf) * SHM_K + kw2) = st_k2; } while (0)
    SLOAD(0);
    bf16x8 qr[NQREG];
    { const int q_s0 = ((rowbase + q0 + wid * QBLK) * 768 + h * 192) * 2;
      int lp = lane; asm volatile("" : "+v"(lp));
      const int qf_vo = ((lp & 31) * 768 + (lp >> 5) * 8) * 2;
#pragma unroll
      for (int d0 = 0; d0 < NQREG; ++d0) qr[d0] = bload(rQ, qf_vo + d0 * 32, q_s0);
      const int row = lp >> 1, c0 = (lp & 1) * 8; const int qc_vo = (row * 768 + 64 + c0 * 8) * 2;
#pragma unroll
      for (int j = 0; j < 8; ++j) *(ATT_LAS bf16x8*)(QRw + row * QRROW + (c0 + j) * 16) = bload(rQ, qc_vo + j * 16, q_s0); }
    lptr qrb = QRw + r32 * QRROW + hi * 16;
    lptr kbase = K_lds + r32 * KROW + hi * 16;
    lptr vb0 = V_lds + v_rd_base(lane);
    float m_reg = -1e30f, l_reg = 0.f; f32x16 o[4] = {};
#define RESC(a) do { if (__any((a) < 1.f)) { if (hi == 0) al_l[r32] = (a); asm volatile("s_waitcnt lgkmcnt(0)" ::: "memory");              \
                     _Pragma("unroll") for (int d_ = 0; d_ < 4; ++d_) _Pragma("unroll") for (int r = 0; r < 16; ++r) o[d_][r] *= al_l[crow(r, hi)]; } } while (0)
#define MASKT(P0_, P1_, t) do { if (T.pmax[b * 32 + (t)] > qminw) mask_tile_pos(P0_, P1_, pq, rP, hi * 16, (rowbase + (t) * KVBLK) * 4); } while (0)
    f32x16 pA0, pA1, pB0, pB1; float alA, alB; bf16x8 pa0, pa1, pa2, pa3;
    VMW(); SWRITE(0);
    if (NT > 1) SLOAD(1);
    __syncthreads();
    SBAR(); qkt<0>(pA0, pA1, kbase, qrb, qr);
    MASKT(pA0, pA1, 0); partialSM(pA0, pA1, m_reg, alA);
    if (NT > 1) { VMW(); SWRITE(1); }
    __syncthreads();
#define HALF_STEP(PX0, PX1, alX, PY0, PY1, alY, t, KB, VB, SB) do {                                                      \
        SBAR(); qkt<KB>(PX0, PX1, kbase, qrb, qr);                                                                        \
        finishSM(PY0, PY1, alY, l_reg, pa0, pa1, pa2, pa3); SBAR();                                                       \
        if ((t) + 1 < NT) { SLOAD((t) + 1); SBAR(); }                                                                     \
        pv_tile<VB>(o, vb0, pa0, pa1, pa2, pa3); MASKT(PX0, PX1, (t)); partialSM(PX0, PX1, m_reg, alX);                   \
        __syncthreads();                                                                                                  \
        if ((t) + 1 < NT) { VMW(); SWRITE(SB); }                                                                          \
        RESC(alX); __syncthreads(); } while (0)
    for (int t = 1; t + 1 < NT; t += 2) {
        HALF_STEP(pB0, pB1, alB, pA0, pA1, alA, t, 1, 0, 0);
        HALF_STEP(pA0, pA1, alA, pB0, pB1, alB, t + 1, 0, 1, 1);
    }
    const bool even = (NT & 1) == 0;
    if (even) { SBAR(); qkt<1>(pB0, pB1, kbase, qrb, qr); SBAR(); }
    finishSM(pA0, pA1, alA, l_reg, pa0, pa1, pa2, pa3); SBAR();
    pv_tile<0>(o, vb0, pa0, pa1, pa2, pa3);
    if (even) { MASKT(pB0, pB1, NT - 1); partialSM(pB0, pB1, m_reg, alB); RESC(alB);
        finishSM(pB0, pB1, alB, l_reg, pa0, pa1, pa2, pa3); SBAR(); pv_tile<1>(o, vb0, pa0, pa1, pa2, pa3); }
    if (hi == 0) li_l[r32] = l_reg; asm volatile("s_waitcnt lgkmcnt(0)" ::: "memory");
    float rli[16];
#pragma unroll
    for (int r = 0; r < 16; ++r) rli[r] = __builtin_amdgcn_rcpf(li_l[crow(r, hi)]);
    __syncthreads();
    lptr stg = lds + wid * 8192;
#pragma unroll
    for (int r = 0; r < 16; ++r) { const int orow = crow(r, hi);
#pragma unroll
        for (int d0 = 0; d0 < 4; ++d0) *(ATT_LAS unsigned short*)(stg + orow * 256 + (d0 * 32 + r32) * 2) = (unsigned short)(cvtpk(o[d0][r] * rli[r], 0.f) & 0xffffu); }
    asm volatile("s_waitcnt lgkmcnt(0)" ::: "memory");
    { int le = lane; asm volatile("" : "+v"(le)); const int rowl = le >> 4, ch = le & 15; const int g_vo = (rowl * 512 + ch * 8) * 2, y_vo = (rowl * 1024 + ch * 8) * 2;
      const int tok0 = rowbase + q0 + wid * QBLK;
#pragma unroll
      for (int i = 0; i < 8; ++i) {
        const u32x4 ov = *(const ATT_LAS u32x4*)(stg + (i * 4 + rowl) * 256 + ch * 16);
        const u32x4 gv = __builtin_amdgcn_raw_buffer_load_b128(rGA, g_vo, ((tok0 + i * 4) * 512 + h * 128) * 2, 0);
        u32x4 y; y.x = mul_bf16x2(ov.x, gv.x); y.y = mul_bf16x2(ov.y, gv.y); y.z = mul_bf16x2(ov.z, gv.z); y.w = mul_bf16x2(ov.w, gv.w);
        __builtin_amdgcn_raw_buffer_store_b128(y, rY, y_vo, ((tok0 + i * 4) * 1024 + h * 128) * 2, 0); } }
    __syncthreads();
#undef RESC
#undef MASKT
#undef HALF_STEP
#undef SLOAD
#undef SWRITE
#undef VMW
}
#undef SBAR
}
namespace pool {
#define POOL_LAS __attribute__((address_space(3)))
typedef unsigned short bf16_t;
typedef short bf16x8 __attribute__((ext_vector_type(8)));
typedef float f32x16 __attribute__((ext_vector_type(16)));
typedef unsigned u32x4 __attribute__((ext_vector_type(4)));
typedef unsigned u32x2 __attribute__((ext_vector_type(2)));
typedef POOL_LAS char* lptr;
constexpr int ROWB = 272;
constexpr int LDS_A = 0, LDS_W = 256 * ROWB, LDS_BYTES = LDS_W + 128 * ROWB;
typedef float f32x2_t __attribute__((ext_vector_type(2))); typedef __bf16 bf16x2_t __attribute__((ext_vector_type(2)));
__device__ __forceinline__ unsigned cvtpk(float lo, float hi) { f32x2_t v = {lo, hi}; bf16x2_t b = __builtin_convertvector(v, bf16x2_t); return __builtin_bit_cast(unsigned, b); }
__device__ __forceinline__ void unpack8(const u32x4 v, float (&f)[8]) {
    f[0] = __uint_as_float(v.x << 16); f[1] = __uint_as_float(v.x & 0xffff0000u); f[2] = __uint_as_float(v.y << 16); f[3] = __uint_as_float(v.y & 0xffff0000u);
    f[4] = __uint_as_float(v.z << 16); f[5] = __uint_as_float(v.z & 0xffff0000u); f[6] = __uint_as_float(v.w << 16); f[7] = __uint_as_float(v.w & 0xffff0000u);
}
template <int W>
__device__ __forceinline__ void pool_rows(const bf16_t* Ug  , int s0, lptr dst  ) {
    u32x4 rv[W + 7];
#pragma unroll
    for (int j = 0; j < W + 7; ++j) { const int jj = j - (W - 1); const bool ok = (s0 + jj) >= 0;
        const u32x4 v = *(const u32x4*)(Ug + (ptrdiff_t)(ok ? jj : 0) * 512); rv[j] = ok ? v : (u32x4){0u, 0u, 0u, 0u}; }
    float S[8];
#pragma unroll
    for (int c = 0; c < 8; ++c) S[c] = 0.f;
#pragma unroll
    for (int j = 0; j < W - 1; ++j) { float f[8]; unpack8(rv[j], f);
#pragma unroll
        for (int c = 0; c < 8; ++c) S[c] += f[c]; }
#pragma unroll
    for (int i = 0; i < 8; ++i) { float f[8]; unpack8(rv[i + W - 1], f);
#pragma unroll
        for (int c = 0; c < 8; ++c) S[c] += f[c];
        const int cnt = (s0 + i + 1) < W ? (s0 + i + 1) : W; const float ic = 1.0f / (float)cnt;
        u32x4 o; o.x = cvtpk(S[0] * ic - f[0], S[1] * ic - f[1]); o.y = cvtpk(S[2] * ic - f[2], S[3] * ic - f[3]); o.z = cvtpk(S[4] * ic - f[4], S[5] * ic - f[5]); o.w = cvtpk(S[6] * ic - f[6], S[7] * ic - f[7]);
        *(POOL_LAS u32x4*)(dst + i * ROWB) = o;
        float g[8]; unpack8(rv[i], g);
#pragma unroll
        for (int c = 0; c < 8; ++c) S[c] -= g[c]; }
}
struct Tensors { const bf16_t *U, *GB, *PWT; bf16_t* Y; };
__device__ __forceinline__ void pool_unit(int pm, int g, const Tensors& T, lptr lds) {
    const int tid = threadIdx.x, wid = __builtin_amdgcn_readfirstlane(tid >> 6), lane = tid & 63, r32 = lane & 31, hi = lane >> 5;
    __syncthreads();
    { const bf16_t* w = T.PWT + (size_t)g * 128 * 128;
#pragma unroll
      for (int i = 0; i < 4; ++i) { const int id = tid + 512 * i, n = id >> 4, ch = id & 15; *(POOL_LAS u32x4*)(lds + LDS_W + n * ROWB + ch * 16) = *(const u32x4*)(w + n * 128 + ch * 8); } }
    { const int ch = tid & 15, rg = tid >> 4; const size_t tok = (size_t)pm * 256 + rg * 8; const int s0 = (int)(tok & 2047);
      const bf16_t* Ug = T.U + tok * 512 + g * 128 + ch * 8; lptr dst = lds + LDS_A + rg * 8 * ROWB + ch * 16;
      if (g == 0) pool_rows<2>(Ug, s0, dst); else if (g == 1) pool_rows<4>(Ug, s0, dst); else if (g == 2) pool_rows<8>(Ug, s0, dst); else pool_rows<16>(Ug, s0, dst); }
    __syncthreads();
    f32x16 acc[4] = {};
    lptr ab = lds + LDS_W + r32 * ROWB + hi * 16, bb = lds + LDS_A + (wid * 32 + r32) * ROWB + hi * 16;
#pragma unroll
    for (int ks = 0; ks < 8; ++ks) { const bf16x8 bq = *(const POOL_LAS bf16x8*)(bb + ks * 32);
#pragma unroll
        for (int nt = 0; nt < 4; ++nt) { const bf16x8 aw = *(const POOL_LAS bf16x8*)(ab + nt * 32 * ROWB + ks * 32);
            acc[nt] = __builtin_amdgcn_mfma_f32_32x32x16_bf16(aw, bq, acc[nt], 0, 0, 0); } }
    lptr stg = lds + LDS_A + wid * 32 * ROWB;
#pragma unroll
    for (int nt = 0; nt < 4; ++nt)
#pragma unroll
        for (int rq = 0; rq < 4; ++rq) { u32x2 w; w.x = cvtpk(acc[nt][4 * rq], acc[nt][4 * rq + 1]); w.y = cvtpk(acc[nt][4 * rq + 2], acc[nt][4 * rq + 3]);
            *(POOL_LAS u32x2*)(stg + r32 * ROWB + (32 * nt + 8 * rq + 4 * hi) * 2) = w; }
    asm volatile("s_waitcnt lgkmcnt(0)" ::: "memory");
#pragma unroll
    for (int i = 0; i < 8; ++i) { const int row = i * 4 + (lane >> 4), ch = lane & 15; const size_t tok = (size_t)pm * 256 + wid * 32 + row;
        const u32x4 ov = *(const POOL_LAS u32x4*)(stg + row * ROWB + ch * 16);
        const u32x4 gv = *(const u32x4*)(T.GB + tok * 512 + g * 128 + ch * 8);
        u32x4 y; y.x = attn::mul_bf16x2(ov.x, gv.x); y.y = attn::mul_bf16x2(ov.y, gv.y); y.z = attn::mul_bf16x2(ov.z, gv.z); y.w = attn::mul_bf16x2(ov.w, gv.w);
        *(u32x4*)(T.Y + tok * 1024 + 512 + g * 128 + ch * 8) = y; }
}
}
#define GAS __attribute__((address_space(1)))
#define LAS __attribute__((address_space(3)))
typedef unsigned short bf16;
typedef unsigned v4u __attribute__((ext_vector_type(4)));
typedef float f32x4 __attribute__((ext_vector_type(4)));
typedef short bf16x8 __attribute__((ext_vector_type(8)));
typedef GAS unsigned gu32;
typedef GAS unsigned long long gu64;
#define RLX_AGENT __ATOMIC_RELAXED, __HIP_MEMORY_SCOPE_AGENT
#define LDS_WAIT() asm volatile("s_waitcnt lgkmcnt(0)" ::: "memory")
#define VM_WAIT() asm volatile("s_waitcnt vmcnt(0)" ::: "memory")
__device__ __forceinline__ unsigned long long rt() { return __builtin_amdgcn_s_memrealtime(); }
__device__ __forceinline__ unsigned f2bf(float f) { unsigned u = __builtin_bit_cast(unsigned, f); return (u + 0x7fffu + ((u >> 16) & 1u)) >> 16; }
__device__ __forceinline__ unsigned pk2(float lo, float hi) { return f2bf(lo) | (f2bf(hi) << 16); }

#define XB_TMO      128
#define XB_XCNT(j)  (256  + 64 * (j))
#define XB_XSUB(j)  (1280 + 64 * (j))
#define XB_XGEN(j)  (2304 + 64 * (j))
#define XB_TOP      3328
#define XB_TOPGEN   3392
#define XCD_BAR_WORDS 3456
#define XB_SPIN_CAP (1u << 18)

__device__ __forceinline__ unsigned xb_ld(unsigned* p)              { return __hip_atomic_load(p, __ATOMIC_RELAXED, __HIP_MEMORY_SCOPE_AGENT); }
__device__ __forceinline__ unsigned xb_add(unsigned* p, unsigned v) { return __hip_atomic_fetch_add(p, v, __ATOMIC_RELAXED, __HIP_MEMORY_SCOPE_AGENT); }
__device__ __forceinline__ unsigned xb_xcc_id() { return (unsigned)__builtin_amdgcn_s_getreg((3 << 11) | 20) & 0xFu; }
#define XB_SPIN(cond, bar) do { unsigned _sp = 0; while (cond) { __builtin_amdgcn_s_sleep(1); \
    if ((++_sp & 255u) == 0u) { if (xb_ld(&(bar)[XB_TMO])) break; if (_sp > XB_SPIN_CAP) { atomicAdd(&(bar)[XB_TMO], 1u); break; } } } } while (0)

struct XcdBarrier {
    unsigned* bar; unsigned x;
    volatile LAS unsigned* st;
};

__device__ __forceinline__ XcdBarrier xcd_barrier_post(unsigned* bar, volatile LAS unsigned* st) {
    XcdBarrier b; b.bar = bar; b.x = xb_xcc_id(); b.st = st;
    if (threadIdx.x == 0) (void)xb_add(&bar[XB_XCNT(b.x)], 1u);
    return b;
}
__device__ __forceinline__ void xcd_barrier_complete(unsigned* bar, unsigned x, unsigned& nloc, unsigned& nx) {
    const unsigned G = gridDim.x * gridDim.y * gridDim.z;
    unsigned sum, cnt, mine, sp = 0u;
    for (;;) {
        sum = 0u; cnt = 0u; mine = 0u;
#pragma unroll
        for (unsigned j = 0; j < 16; ++j) { const unsigned c = xb_ld(&bar[XB_XCNT(j)]); sum += c; cnt += (c > 0u) ? 1u : 0u; mine = (j == x) ? c : mine; }
        if (sum == G) break;
        __builtin_amdgcn_s_sleep(1);
        if ((++sp & 255u) == 0u) { if (xb_ld(&bar[XB_TMO])) break; if (sp > XB_SPIN_CAP) { atomicAdd(&bar[XB_TMO], 1u); break; } }
    }
    nloc = mine > 0u ? mine : 1u; nx = cnt > 0u ? cnt : 1u;
}

__device__ __forceinline__ void xcd_barrier(const XcdBarrier& b) {
    asm volatile("s_waitcnt vmcnt(0)" ::: "memory");
    __syncthreads();
    if (threadIdx.x == 0) {
        unsigned* bar = b.bar;
        __builtin_amdgcn_s_waitcnt(0);
        unsigned nloc = b.st[0], nx = b.st[1];
        if (nloc == 0u) { xcd_barrier_complete(bar, b.x, nloc, nx); b.st[0] = nloc; b.st[1] = nx; }
        const unsigned old = xb_add(&bar[XB_XSUB(b.x)], 1u);
        const unsigned gen = old / nloc;
        if (old + 1u == (gen + 1u) * nloc) {
            __builtin_amdgcn_fence(__ATOMIC_RELEASE, "agent");
            asm volatile("s_waitcnt vmcnt(0)" ::: "memory");
            const unsigned og = xb_add(&bar[XB_TOP], 1u);
            const unsigned tg = og / nx;
            if (og + 1u == (tg + 1u) * nx) xb_add(&bar[XB_TOPGEN], 1u);
            else XB_SPIN(xb_ld(&bar[XB_TOPGEN]) == tg, bar);
            __builtin_amdgcn_fence(__ATOMIC_ACQUIRE, "agent");
            xb_add(&bar[XB_XGEN(b.x)], 1u);
            asm volatile("s_waitcnt vmcnt(0)" ::: "memory");
        } else {
            XB_SPIN(xb_ld(&bar[XB_XGEN(b.x)]) == gen, bar);
            __builtin_amdgcn_fence(__ATOMIC_ACQUIRE, "agent");
            asm volatile("s_waitcnt vmcnt(0)" ::: "memory");
        }
    }
    __syncthreads();
}
constexpr int NWAVES = 8;
#ifndef MK_N_LAUNCHES
#define MK_N_LAUNCHES 1
#endif
constexpr int N_LAUNCHES = MK_N_LAUNCHES;
constexpr int PER_PHASE = 5;

constexpr int BATCH = 32, SEQ = 2048, D = 1024, M = BATCH * SEQ;
constexpr int NIN = 2560;
constexpr float LN_EPS = 1e-5f;
constexpr float ALPHA = 1.189207115002721f;

constexpr size_t MiB = 1u << 20;
constexpr size_t WS_CTL = 0, CTL_ZERO_BYTES = 1 * MiB;
constexpr size_t WS_WIN = 2 * MiB, WS_WUQ = 7 * MiB, WS_WUKV = 8 * MiB, WS_PW = 8 * MiB + 512 * 1024, WS_WOUT = 9 * MiB;
constexpr size_t WS_POSMM = 11 * MiB;
constexpr size_t WS_XCH = 12 * MiB, WS_SSQ = 14 * MiB, WS_SSKV = 16 * MiB;
constexpr size_t WS_KR = 24 * MiB, WS_XB = 32 * MiB, WS_Y = 32 * MiB  , WS_XQ = 160 * MiB, WS_XKV = 224 * MiB;
constexpr size_t WS_GA = 256 * MiB, WS_U = 320 * MiB, WS_GB = 384 * MiB, WS_Q = 448 * MiB, WS_KN = 544 * MiB, WS_VV = 608 * MiB, WS_END = 672 * MiB;
constexpr int CW_TMO = 0, CW_CODE = 1;
constexpr int CW_BAR = 4096;
constexpr int CW_SEAM = 32768;
static_assert((CW_SEAM + 256 * 64) * 4 <= (int)CTL_ZERO_BYTES, "CTL words inside the memset region");

constexpr int RING_OFF = 0, RING_BYTES = 157696;
constexpr int LDSCTL_OFF = RING_BYTES, MISC_OFF = LDSCTL_OFF + 320;
constexpr int RSTAT_OFF = 131072;
constexpr int LDS_BYTES = 158208;
static_assert(MISC_OFF + 128 <= LDS_BYTES && attn::LDS_BYTES <= RING_BYTES && pool::LDS_BYTES <= RING_BYTES, "LDS map");

struct Frame {
    LAS unsigned char* lds;
    volatile LAS unsigned* MISC;
    gu32* ctl;
    int tid, lane, wave;
    int vcu, G;
};

__device__ __forceinline__ int rope_orig(int p) { return 16 * (p >> 5) + 4 * ((p >> 3) & 3) + (p & 3) + 32 * ((p >> 2) & 1); }
struct Args { const void* in[12]; float* out; unsigned char* ws; int ph_lo, ph_hi, li, pad; };

__device__ __forceinline__ void p0_prologue(const Frame& F, const Args& a) {
    const float* x = (const float*)a.in[0]; const int* pos = (const int*)a.in[1]; const float* w_in = (const float*)a.in[2]; const float* qg = (const float*)a.in[3];
    const float* w_uq = (const float*)a.in[4]; const float* kvg = (const float*)a.in[5]; const float* w_ukv = (const float*)a.in[6]; const float* pool_w = (const float*)a.in[7];
    const float* pool_scale = (const float*)a.in[8]; const float* w_out = (const float*)a.in[9];
    unsigned char* ws = a.ws;
    const size_t gt = (size_t)F.vcu * 512 + F.tid, NTH = (size_t)F.G * 512;
    { const f32x4* x4 = (const f32x4*)x; v4u* xb = (v4u*)(ws + WS_XB);
      for (size_t i = gt; i < (size_t)M * D / 8; i += NTH) { const f32x4 p = x4[2 * i], q = x4[2 * i + 1]; v4u o; o.x = pk2(p[0], p[1]); o.y = pk2(p[2], p[3]); o.z = pk2(q[0], q[1]); o.w = pk2(q[2], q[3]); xb[i] = o; } }
    { bf16* wt = (bf16*)(ws + WS_WIN);
      for (size_t idx = gt; idx < (size_t)NIN * 128; idx += NTH) { const int n = (int)(idx % NIN), kc = (int)(idx / NIN);
          int src; if (n < 768) src = n; else if (n < 2304) src = n + 64; else { const int p = n - 2304; src = p < 64 ? 768 + rope_orig(p) : -1; }
          float v[8];
#pragma unroll
          for (int j = 0; j < 8; ++j) v[j] = src >= 0 ? w_in[(size_t)(8 * kc + j) * 2368 + src] : 0.f;
          v4u o; o.x = pk2(v[0], v[1]); o.y = pk2(v[2], v[3]); o.z = pk2(v[4], v[5]); o.w = pk2(v[6], v[7]); *(v4u*)(wt + (size_t)n * 1024 + 8 * kc) = o; } }
    { bf16* wt = (bf16*)(ws + WS_WUQ);
      for (size_t idx = gt; idx < (size_t)768 * 64; idx += NTH) { const int c = (int)(idx % 768), kc = (int)(idx / 768);
          int src; if (c < 512) src = (c >> 7) * 192 + (c & 127); else { const int cc = c - 512; src = (cc >> 6) * 192 + 128 + rope_orig(cc & 63); }
          float v[8];
#pragma unroll
          for (int j = 0; j < 8; ++j) v[j] = qg[8 * kc + j] * w_uq[(size_t)(8 * kc + j) * 768 + src];
          v4u o; o.x = pk2(v[0], v[1]); o.y = pk2(v[2], v[3]); o.z = pk2(v[4], v[5]); o.w = pk2(v[6], v[7]); *(v4u*)(wt + (size_t)c * 512 + 8 * kc) = o; } }
    { bf16* wt = (bf16*)(ws + WS_WUKV);
      for (size_t idx = gt; idx < (size_t)1024 * 32; idx += NTH) { const int c = (int)(idx % 1024), kc = (int)(idx / 1024);
          float v[8];
#pragma unroll
          for (int j = 0; j < 8; ++j) v[j] = kvg[8 * kc + j] * w_ukv[(size_t)(8 * kc + j) * 1024 + c];
          v4u o; o.x = pk2(v[0], v[1]); o.y = pk2(v[2], v[3]); o.z = pk2(v[4], v[5]); o.w = pk2(v[6], v[7]); *(v4u*)(wt + (size_t)c * 256 + 8 * kc) = o; } }
    { bf16* wt = (bf16*)(ws + WS_PW);
      for (size_t idx = gt; idx < (size_t)512 * 16; idx += NTH) { const int gd = (int)(idx % 512), kc = (int)(idx / 512), g = gd >> 7, d = gd & 127; const float sc = pool_scale[gd];
          float v[8];
#pragma unroll
          for (int j = 0; j < 8; ++j) v[j] = sc * pool_w[((size_t)g * 128 + 8 * kc + j) * 128 + d];
          v4u o; o.x = pk2(v[0], v[1]); o.y = pk2(v[2], v[3]); o.z = pk2(v[4], v[5]); o.w = pk2(v[6], v[7]); *(v4u*)(wt + (size_t)gd * 128 + 8 * kc) = o; } }
    { bf16* wt = (bf16*)(ws + WS_WOUT);
      for (size_t idx = gt; idx < (size_t)1024 * 128; idx += NTH) { const int c = (int)(idx % 1024), kc = (int)(idx / 1024);
          float v[8];
#pragma unroll
          for (int j = 0; j < 8; ++j) v[j] = w_out[(size_t)(8 * kc + j) * 1024 + c];
          v4u o; o.x = pk2(v[0], v[1]); o.y = pk2(v[2], v[3]); o.z = pk2(v[4], v[5]); o.w = pk2(v[6], v[7]); *(v4u*)(wt + (size_t)c * 1024 + 8 * kc) = o; } }
    { int* pmin = (int*)(ws + WS_POSMM); int* pmax = pmin + 1024; int* hmin = pmin + 2048;
      for (int it = F.vcu * NWAVES + F.wave; it < BATCH * 32; it += F.G * NWAVES) { const int v = pos[(size_t)it * 64 + F.lane]; int mn = v, mx = v;
#pragma unroll
          for (int o = 1; o < 32; o <<= 1) { mn = min(mn, __shfl_xor(mn, o)); mx = max(mx, __shfl_xor(mx, o)); }
          const int mno = __shfl_xor(mn, 32), mxo = __shfl_xor(mx, 32);
          if (F.lane == 0) { pmin[it] = min(mn, mno); pmax[it] = max(mx, mxo); hmin[2 * it] = mn; hmin[2 * it + 1] = mno; } } }
}

__global__ void __launch_bounds__(NWAVES * 64, 2) mk_fwd(Args args) {
    extern __shared__ __attribute__((aligned(16))) unsigned char lds[];
    Frame F;
    F.lds = (LAS unsigned char*)lds;
    F.MISC = (volatile LAS unsigned*)(F.lds + MISC_OFF);
    F.tid = threadIdx.x; F.lane = F.tid & 63; F.wave = __builtin_amdgcn_readfirstlane(F.tid >> 6);
    F.G = gridDim.x; { const int bx = blockIdx.x; F.vcu = (F.G % 8 == 0) ? (bx % 8) * (F.G / 8) + bx / 8 : bx; }
#define GRID_BAR(seam) do { if (N_LAUNCHES == PER_PHASE) { if (F.tid == 0) __hip_atomic_store(F.ctl + CW_TMO, 0xBADBA0u | (unsigned)(seam), RLX_AGENT); } \
    else { xcd_barrier(bar); } } while (0)
    unsigned char* ws = args.ws;
    F.ctl = (gu32*)(ws + WS_CTL);
    for (int u = F.tid; u < (LDS_BYTES - LDSCTL_OFF) / 4; u += NWAVES * 64) ((LAS unsigned*)(F.lds + LDSCTL_OFF))[u] = 0u;
    __syncthreads();
    XcdBarrier bar; bar.bar = (unsigned*)(F.ctl + CW_BAR); bar.x = 0; bar.st = nullptr;
    if (N_LAUNCHES != PER_PHASE) bar = xcd_barrier_post((unsigned*)(F.ctl + CW_BAR), F.MISC + 8);
    const int lo = args.ph_lo, hi = args.ph_hi;
#ifndef PH_MASK
#define PH_MASK 31
#endif
#define IN(k) (((PH_MASK >> (k)) & 1) && lo <= (k) && (k) < hi)
#define BOTH(k) (IN(k) && IN((k) + 1))
    typedef pg8::bf16_t b16;
    b16* XB = (b16*)(ws + WS_XB); b16* Y = (b16*)(ws + WS_Y); b16* XQ = (b16*)(ws + WS_XQ); b16* XKV = (b16*)(ws + WS_XKV); b16* KR = (b16*)(ws + WS_KR);
    b16* GA = (b16*)(ws + WS_GA); b16* U = (b16*)(ws + WS_U); b16* GB = (b16*)(ws + WS_GB); b16* Q = (b16*)(ws + WS_Q); b16* KN = (b16*)(ws + WS_KN); b16* VV = (b16*)(ws + WS_VV);
    float* SSQ = (float*)(ws + WS_SSQ); float* SSKV = (float*)(ws + WS_SSKV);
    const int* pos = (const int*)args.in[1];
    const int* pmin = (const int*)(ws + WS_POSMM); const int* pmax = pmin + 1024; const int* hmin = pmin + 2048;

    if (IN(0)) { p0_prologue(F, args); if (BOTH(0)) GRID_BAR(0); }

    if (IN(1)) {
        pg8::Gemm g{XB, (const b16*)(ws + WS_WIN), M, NIN, D}; pg8::StaticOrder S; S.init(M, NIN, F.G, (int)blockIdx.x);
        pg8::EpiP1 E{XQ, XKV, GA, U, GB, KR, SSQ, SSKV, pos};
        pg8::gemm_phase<pg8::EpiP1, pg8::StaticOrder, PG8_ALIGN, PG8_SP2>(F.lds + RING_OFF, g, S, E);
        if (BOTH(1)) GRID_BAR(1);
    }

    if (IN(2)) {
        { pg8::Gemm g{XQ, (const b16*)(ws + WS_WUQ), M, 768, 512}; pg8::StaticOrder S; S.init(M, 768, F.G, (int)blockIdx.x);
          pg8::EpiQ E{Q, SSQ, pos};
          pg8::gemm_phase<pg8::EpiQ, pg8::StaticOrder, PG8_ALIGN, PG8_SP2>(F.lds + RING_OFF, g, S, E); }
        { pg8::Gemm g{XKV, (const b16*)(ws + WS_WUKV), M, 1024, 256}; pg8::StaticOrder S; S.init(M, 1024, F.G, (int)blockIdx.x);
          pg8::EpiKV E{KN, VV, SSKV};
          pg8::gemm_phase<pg8::EpiKV, pg8::StaticOrder, PG8_ALIGN, PG8_SP2>(F.lds + RING_OFF, g, S, E); }
        { const pool::Tensors PT{U, GB, (const b16*)(ws + WS_PW), Y};
          int i = 0;
          for (int L = F.vcu; L < (M / 256) * 4; L += F.G, ++i) pool::pool_unit(L >> 2, ((L & 3) + i) & 3, PT, (pool::lptr)(F.lds + RING_OFF));
          __syncthreads(); }
        if (BOTH(2)) GRID_BAR(2);
    }

    if (IN(3)) {
        const attn::Tensors AT{Q, KN, KR, VV, GA, Y, pos, pmin, pmax, hmin};
        for (int it = F.vcu; it < BATCH * 4 * 2; it += F.G) { const int bh = it >> 1, s = 2 * (it & 1);
#pragma unroll 1
            for (int k = 0; k < 4; ++k) { const int qb = (k == 0) ? s : (k == 1) ? 7 - s : (k == 2) ? s + 1 : 6 - s;
                attn::attn_unit(bh >> 2, bh & 3, qb, AT, (attn::lptr)(F.lds + RING_OFF)); } }
        if (BOTH(3)) GRID_BAR(3);
    }

    if (IN(4)) {
        LAS float* rst = (LAS float*)(F.lds + RSTAT_OFF);
        for (int i = F.tid; i < 4 * 256 * 2; i += NWAVES * 64) rst[i] = 0.f;
        __syncthreads();
        for (int pm = (int)blockIdx.x; pm < M / 256; pm += F.G) {
            const pg8::Gemm g{Y, (const b16*)(ws + WS_WOUT), M, D, D}; const pg8::PanelOrder S{D / 256, pm};
            const pg8::EpiOutZ E{(const float*)args.in[0], args.out, rst};
            pg8::gemm_phase<pg8::EpiOutZ, pg8::PanelOrder, PG8_ALIGN, PG8_SP2>(F.lds + RING_OFF, g, S, E);
            asm volatile("s_waitcnt vmcnt(0) lgkmcnt(0)" ::: "memory"); __syncthreads();
            const float* lng = (const float*)args.in[10]; const float* lnb = (const float*)args.in[11];
            f32x4 gv[4], bv[4];
#pragma unroll
            for (int j = 0; j < 4; ++j) { gv[j] = *(const f32x4*)(lng + 4 * F.lane + 256 * j); bv[j] = *(const f32x4*)(lnb + 4 * F.lane + 256 * j); }
            for (int rr = 0; rr < 32; ++rr) { const int row = F.wave * 32 + rr;
                float s = 0.f, q = 0.f;
#pragma unroll
                for (int w = 0; w < 4; ++w) { s += rst[(w * 256 + row) * 2]; q += rst[(w * 256 + row) * 2 + 1]; }
                const float mean = s * (1.0f / 1024.0f); const float var = fmaxf(q * (1.0f / 1024.0f) - mean * mean, 0.f); const float rstd = 1.0f / sqrtf(var + LN_EPS);
                GAS f32x4* zr = (GAS f32x4*)(args.out + ((size_t)pm * 256 + row) * 1024) + F.lane;
                f32x4 v[4];
#pragma unroll
                for (int j = 0; j < 4; ++j) v[j] = __builtin_nontemporal_load(zr + 64 * j);
#pragma unroll
                for (int j = 0; j < 4; ++j) zr[64 * j] = (v[j] - mean) * rstd * gv[j] + bv[j]; }
            __syncthreads();
            for (int i = F.tid; i < 4 * 256 * 2; i += NWAVES * 64) rst[i] = 0.f;
            __syncthreads();
        }
    }
#undef IN
#undef BOTH
}


#ifdef DBG_SEL
__device__ __forceinline__ float dbg_b2f(const unsigned short* p, size_t i) { return __uint_as_float(((unsigned)p[i]) << 16); }
__global__ void dbg_dump(unsigned char* ws, float* out, int sel) {
    const size_t n = (size_t)M * D;
    for (size_t i = blockIdx.x * (size_t)blockDim.x + threadIdx.x; i < n; i += (size_t)gridDim.x * blockDim.x) {
        float v = 0.f;
        if (sel == 1) { v = dbg_b2f((const unsigned short*)(ws + WS_XQ), i % ((size_t)M * 512)) + dbg_b2f((const unsigned short*)(ws + WS_XKV), i % ((size_t)M * 256)) + dbg_b2f((const unsigned short*)(ws + WS_GA), i % ((size_t)M * 512))
                        + dbg_b2f((const unsigned short*)(ws + WS_U), i % ((size_t)M * 512)) + dbg_b2f((const unsigned short*)(ws + WS_GB), i % ((size_t)M * 512)) + dbg_b2f((const unsigned short*)(ws + WS_KR), i % ((size_t)M * 64))
                        + ((const float*)(ws + WS_SSQ))[i % ((size_t)M * 8)] + ((const float*)(ws + WS_SSKV))[i % ((size_t)M * 4)]; }
        else if (sel == 2) { v = dbg_b2f((const unsigned short*)(ws + WS_Q), i % ((size_t)M * 768)) + dbg_b2f((const unsigned short*)(ws + WS_KN), i % ((size_t)M * 512)) + dbg_b2f((const unsigned short*)(ws + WS_VV), i % ((size_t)M * 512)); }
        else if (sel == 3) { const size_t r = i / 1024, c = i % 1024; v = c >= 512 ? dbg_b2f((const unsigned short*)(ws + WS_Y), r * 1024 + c) : 0.f; }
        else if (sel == 4) { const size_t r = i / 1024, c = i % 1024; v = c < 512 ? dbg_b2f((const unsigned short*)(ws + WS_Y), r * 1024 + c) : 0.f; }
        else if (sel == 5) { v = dbg_b2f((const unsigned short*)(ws + WS_WIN), i % ((size_t)NIN * 1024)) + dbg_b2f((const unsigned short*)(ws + WS_WUQ), i % ((size_t)768 * 512)) + dbg_b2f((const unsigned short*)(ws + WS_WUKV), i % ((size_t)1024 * 256))
                        + dbg_b2f((const unsigned short*)(ws + WS_PW), i % ((size_t)512 * 128)) + dbg_b2f((const unsigned short*)(ws + WS_WOUT), i % ((size_t)1024 * 1024)) + dbg_b2f((const unsigned short*)(ws + WS_XB), i) + (float)((const int*)(ws + WS_POSMM))[i % 4096]; }
        out[i] = v;
    }
}
#endif
extern "C" void kernel_launch(void* const* d_in, const int* in_sizes, int n_in, void* d_out, int out_size, void* d_ws, size_t ws_size, hipStream_t stream) {
    static int grid = 0;
    if (grid == 0) {
        if (n_in != 12 || in_sizes[0] != M * D || out_size != M * D || ws_size < WS_END) { fprintf(stderr, "kernel_launch: shape/workspace mismatch (n_in %d in0 %d out %d ws %zu, need ws >= %zu)\n", n_in, n_in > 0 ? in_sizes[0] : -1, out_size, ws_size, (size_t)WS_END); grid = -1; return; }
        int dev = 0, cus = 0, per_cu = 0;
        if (hipGetDevice(&dev) != hipSuccess || hipDeviceGetAttribute(&cus, hipDeviceAttributeMultiprocessorCount, dev) != hipSuccess) { fprintf(stderr, "kernel_launch: device query failed\n"); grid = -1; return; }
        if (hipFuncSetAttribute((const void*)mk_fwd, hipFuncAttributeMaxDynamicSharedMemorySize, LDS_BYTES) != hipSuccess) { fprintf(stderr, "kernel_launch: hipFuncSetAttribute failed\n"); grid = -1; return; }
        if (hipOccupancyMaxActiveBlocksPerMultiprocessor(&per_cu, (const void*)mk_fwd, NWAVES * 64, LDS_BYTES) != hipSuccess || per_cu < 1) fprintf(stderr, "kernel_launch: note: occupancy query reports %d workgroups per CU\n", per_cu);
        (void)hipGetLastError();
        grid = cus;
        if (grid != 256) fprintf(stderr, "kernel_launch: %d CUs; the fused LayerNorm phase needs 256\n", grid);
    }
    if (grid < 0) return;
    if (hipMemsetAsync((char*)d_ws + WS_CTL, 0, CTL_ZERO_BYTES, stream) != hipSuccess) { fprintf(stderr, "kernel_launch: hipMemsetAsync failed\n"); return; }
    Args a{};
    for (int i = 0; i < 12; ++i) a.in[i] = d_in[i];
    a.out = (float*)d_out; a.ws = (unsigned char*)d_ws;
#ifdef DBG_SEL
    for (int li = 0; li <= DBG_UPTO; ++li) { a.ph_lo = li; a.ph_hi = li + 1; a.li = li; hipLaunchKernelGGL(mk_fwd, dim3(grid), dim3(NWAVES * 64), LDS_BYTES, stream, a); }
    hipLaunchKernelGGL(dbg_dump, dim3(2048), dim3(256), 0, stream, (unsigned char*)d_ws, (float*)d_out, DBG_SEL);
    return;
#endif
    for (int li = 0; li < N_LAUNCHES; ++li) {
        a.ph_lo = (N_LAUNCHES == PER_PHASE) ? li : 0; a.ph_hi = (N_LAUNCHES == PER_PHASE) ? li + 1 : PER_PHASE; a.li = li;
        hipLaunchKernelGGL(mk_fwd, dim3(grid), dim3(NWAVES * 64), LDS_BYTES, stream, a);
        const hipError_t le = hipPeekAtLastError();
        if (le != hipSuccess) { fprintf(stderr, "kernel_launch: launch %d failed: %s\n", li, hipGetErrorName(le)); break; }
    }
}
```

```cpp
#define FUSE34 1
#define FUSE34_KROT 1
#define POOL_GPF 1
#define ATT_GPF 1
#define ATT_MPLDS 1
#define ONE_TRIM 1
#define LN_SLOTS_WIDE 1
#include <hip/hip_runtime.h>
#include <cstdio>
#include <cstdint>
#define GAS __attribute__((address_space(1)))
#define LAS __attribute__((address_space(3)))
typedef unsigned short bf16;
typedef unsigned v4u __attribute__((ext_vector_type(4)));
typedef float f32x4 __attribute__((ext_vector_type(4)));
typedef short bf16x8 __attribute__((ext_vector_type(8)));
typedef GAS unsigned gu32;
typedef GAS unsigned long long gu64;
#define RLX_AGENT __ATOMIC_RELAXED, __HIP_MEMORY_SCOPE_AGENT
#define LDS_WAIT() asm volatile("s_waitcnt lgkmcnt(0)" ::: "memory")
#define VM_WAIT() asm volatile("s_waitcnt vmcnt(0)" ::: "memory")
__device__ __forceinline__ unsigned long long rt() { return __builtin_amdgcn_s_memrealtime(); }
__device__ __forceinline__ unsigned f2bf(float f) { unsigned u = __builtin_bit_cast(unsigned, f); return (u + 0x7fffu + ((u >> 16) & 1u)) >> 16; }
__device__ __forceinline__ unsigned pk2(float lo, float hi) { return f2bf(lo) | (f2bf(hi) << 16); }

#define XB_TMO      128
#define XB_XCNT(j)  (256  + 64 * (j))
#define XB_XSUB(j)  (1280 + 64 * (j))
#define XB_XGEN(j)  (2304 + 64 * (j))
#define XB_TOP      3328
#define XB_TOPGEN   3392
#define XCD_BAR_WORDS 3456
#define XB_SPIN_CAP (1u << 18)

__device__ __forceinline__ unsigned xb_ld(unsigned* p)              { return __hip_atomic_load(p, __ATOMIC_RELAXED, __HIP_MEMORY_SCOPE_AGENT); }
__device__ __forceinline__ unsigned xb_add(unsigned* p, unsigned v) { return __hip_atomic_fetch_add(p, v, __ATOMIC_RELAXED, __HIP_MEMORY_SCOPE_AGENT); }
__device__ __forceinline__ unsigned xb_xcc_id() { return (unsigned)__builtin_amdgcn_s_getreg((3 << 11) | 20) & 0xFu; }
#define XB_SPIN(cond, bar) do { unsigned _sp = 0; while (cond) { __builtin_amdgcn_s_sleep(1); \
    if ((++_sp & 255u) == 0u) { if (xb_ld(&(bar)[XB_TMO])) break; if (_sp > XB_SPIN_CAP) { atomicAdd(&(bar)[XB_TMO], 1u); break; } } } } while (0)

struct XcdBarrier {
    unsigned* bar; unsigned x;
    volatile LAS unsigned* st;
};

__device__ __forceinline__ XcdBarrier xcd_barrier_post(unsigned* bar, volatile LAS unsigned* st) {
    XcdBarrier b; b.bar = bar; b.x = xb_xcc_id(); b.st = st;
    if (threadIdx.x == 0) (void)xb_add(&bar[XB_XCNT(b.x)], 1u);
    return b;
}
__device__ __forceinline__ void xcd_barrier_complete(unsigned* bar, unsigned x, unsigned& nloc, unsigned& nx) {
    const unsigned G = gridDim.x * gridDim.y * gridDim.z;
    unsigned sum, cnt, mine, sp = 0u;
    for (;;) {
        sum = 0u; cnt = 0u; mine = 0u;
#pragma unroll
        for (unsigned j = 0; j < 16; ++j) { const unsigned c = xb_ld(&bar[XB_XCNT(j)]); sum += c; cnt += (c > 0u) ? 1u : 0u; mine = (j == x) ? c : mine; }
        if (sum == G) break;
        __builtin_amdgcn_s_sleep(1);
        if ((++sp & 255u) == 0u) { if (xb_ld(&bar[XB_TMO])) break; if (sp > XB_SPIN_CAP) { atomicAdd(&bar[XB_TMO], 1u); break; } }
    }
    nloc = mine > 0u ? mine : 1u; nx = cnt > 0u ? cnt : 1u;
}

__device__ __forceinline__ void xcd_barrier(const XcdBarrier& b) {
    asm volatile("s_waitcnt vmcnt(0)" ::: "memory");
    __syncthreads();
    if (threadIdx.x == 0) {
        unsigned* bar = b.bar;
        __builtin_amdgcn_s_waitcnt(0);
        unsigned nloc = b.st[0], nx = b.st[1];
        if (nloc == 0u) { xcd_barrier_complete(bar, b.x, nloc, nx); b.st[0] = nloc; b.st[1] = nx; }
#ifdef BAR_EARLY_WB
        __builtin_amdgcn_fence(__ATOMIC_RELEASE, "agent");
#endif
        const unsigned old = xb_add(&bar[XB_XSUB(b.x)], 1u);
        const unsigned gen = old / nloc;
        if (old + 1u == (gen + 1u) * nloc) {
            __builtin_amdgcn_fence(__ATOMIC_RELEASE, "agent");
            asm volatile("s_waitcnt vmcnt(0)" ::: "memory");
            const unsigned og = xb_add(&bar[XB_TOP], 1u);
            const unsigned tg = og / nx;
            if (og + 1u == (tg + 1u) * nx) xb_add(&bar[XB_TOPGEN], 1u);
            else XB_SPIN(xb_ld(&bar[XB_TOPGEN]) == tg, bar);
            __builtin_amdgcn_fence(__ATOMIC_ACQUIRE, "agent");
            xb_add(&bar[XB_XGEN(b.x)], 1u);
            asm volatile("s_waitcnt vmcnt(0)" ::: "memory");
        } else {
            XB_SPIN(xb_ld(&bar[XB_XGEN(b.x)]) == gen, bar);
            __builtin_amdgcn_fence(__ATOMIC_ACQUIRE, "agent");
            asm volatile("s_waitcnt vmcnt(0)" ::: "memory");
        }
    }
    __syncthreads();
}
#include <hip/hip_runtime.h>
#include <cstdio>
#include <cstdint>
namespace pg8 {
#define PG8_LAS __attribute__((address_space(3)))
typedef unsigned short bf16_t;
typedef short bf16x8 __attribute__((ext_vector_type(8)));
typedef float f32x4 __attribute__((ext_vector_type(4)));
typedef unsigned u32x4 __attribute__((ext_vector_type(4)));
constexpr int BM = 256, BK = 64, HALF = 128, HTB = HALF * BK * 2  , STAGE_BYTES = 8 * HTB, NXCD = 8, WGM = 8;

__host__ __device__ __forceinline__ int lds_byte(int r, int c) { const int st = (r >> 4) * 2 + (c >> 5), rr = r & 15, cc = c & 31, ob = rr * 64 + cc * 2; return st * 1024 + (ob ^ (((ob >> 9) & 1) << 5)); }
__host__ __device__ __forceinline__ void stage_rc(int b, int& R, int& C) { const int st = b / 1024, sb = b % 1024, swz = sb ^ (((sb >> 9) & 1) << 5); R = (st >> 1) * 16 + swz / 64; C = (st & 1) * 32 + (swz % 64) / 2; }
__host__ __device__ __forceinline__ int perm32(int rho) { const int n = rho >> 4, i = rho & 15; return 8 * (i >> 2) + 4 * n + (i & 3); }

struct Unit { int pm, pn, dummy; };
struct Gemm { const bf16_t* A; const bf16_t* Bt; int M, N, K; };

struct StaticOrder {
    static constexpr bool SINGLE = false;
    int nM, nN, nwg, G, c;
    __host__ __device__ void init(int M, int N, int G_, int c_) { nM = M / BM; nN = N / BM; nwg = nM * nN; G = G_; c = c_; }
    __host__ __device__ bool next(int i, Unit& u) const {
        const long L = (long)i * G + c; if (L >= nwg) return false;
        int wgid = (int)L; { const int q = nwg / NXCD, r = nwg % NXCD, xcd = wgid % NXCD, off = wgid / NXCD; wgid = (xcd < r ? xcd * (q + 1) : r * (q + 1) + (xcd - r) * q) + off; }
        const int nig = WGM * nN, gid = wgid / nig, fm = gid * WGM, gsz = (nM - fm) < WGM ? (nM - fm) : WGM;
        u.pm = fm + ((wgid % nig) % gsz); u.pn = (wgid % nig) / gsz; u.dummy = 0; return true;
    }
    __device__ __forceinline__ void a_ready(const Unit&) const {}
    __device__ __forceinline__ void done(const Unit&) const {}
};

__device__ __forceinline__ unsigned cvt_pk_bf16(float lo, float hi) { unsigned r; asm volatile("v_cvt_pk_bf16_f32 %0, %1, %2" : "=v"(r) : "v"(lo), "v"(hi)); return r; }
#ifdef RD_NT
#define RDX_AUX ((RD_NT) & 1 ? 2 : 0)
#define RDQ_AUX ((RD_NT) & 2 ? 2 : 0)
#define RDP_NT (((RD_NT) & 4) != 0)
#else
#define RDX_AUX 0
#define RDQ_AUX 0
#define RDP_NT 0
#endif
#ifndef GB_SILU_IN_POOL
#define GB_SILU_IN_POOL 1
#endif
#ifndef GA_SILU_IN_ATTN
#define GA_SILU_IN_ATTN 0
#endif
#ifdef NT_EPI
#define NTST(addr, val) __builtin_nontemporal_store((val), (u32x4*)(addr))
#define NT_AUX 2
#else
#define NTST(addr, val) (*(u32x4*)(addr) = (val))
#define NT_AUX 0
#endif
__device__ __forceinline__ float silu_f(float x) { return x * __builtin_amdgcn_rcpf(1.0f + __builtin_amdgcn_exp2f(-1.4426950408889634f * x)); }
__device__ __forceinline__ void sincos_rad(float ang, float& s, float& c) {
    const float I2PI_HI = 0.15915494f, I2PI_LO = 6.4206383e-9f;
    const float k = __builtin_rintf(ang * I2PI_HI);
    float r = __builtin_fmaf(ang, I2PI_HI, -k);
    r = __builtin_fmaf(ang, I2PI_LO, r);
    s = __builtin_amdgcn_sinf(r); c = __builtin_amdgcn_cosf(r);
}
__device__ __forceinline__ float rope_inv_freq(int j) { return exp2f(-(float)j * 0.41524101186092029f); }
typedef float f32x2_t __attribute__((ext_vector_type(2))); typedef __bf16 bf16x2_t __attribute__((ext_vector_type(2)));
__device__ __forceinline__ unsigned cvtpk_c(float lo, float hi) { f32x2_t v = {lo, hi}; bf16x2_t b = __builtin_convertvector(v, bf16x2_t); return __builtin_bit_cast(unsigned, b); }
__device__ __forceinline__ u32x4 pack8f(const f32x4 a, const f32x4 b) { u32x4 w; w.x = cvtpk_c(a[0], a[1]); w.y = cvtpk_c(a[2], a[3]); w.z = cvtpk_c(b[0], b[1]); w.w = cvtpk_c(b[2], b[3]); return w; }

struct EpiP1 {
    static constexpr bool PERM = true, AFTER_DRAIN = false, INIT_ACC = false, XRES = false, HAS_NARROW = true, KHOOK = false; static constexpr int KROT = 0;
    __device__ __forceinline__ bool narrow(const Unit& u) const { return u.pn == 9; }
    __device__ __forceinline__ int nst(const Unit& u) const { return u.pn == 9 ? 0 : 16; }
    bf16_t *XQ, *XKV, *GA, *U, *GB, *KR; float* SSQ; PG8_LAS float* red; const int* pos;
    template <bool ACT, bool SQ>
    __device__ __forceinline__ void body(const f32x4 (&acc)[2][2][4][2], bf16_t* dst, int colt, float* ss, int part, int row0, int wc, int fq) const {
        const int col0 = colt + wc * 32 + 8 * fq;
#pragma unroll
        for (int ai = 0; ai < 2; ++ai)
#pragma unroll
            for (int m = 0; m < 4; ++m) { const int row = row0 + ai * HALF + m * 16; bf16_t* rowp = dst + (size_t)row * 512 + col0; float sq = 0.f;
#pragma unroll
                for (int bj = 0; bj < 2; ++bj) { f32x4 v0 = acc[ai][bj][m][0], v1 = acc[ai][bj][m][1];
                    if constexpr (ACT) {
#pragma unroll
                        for (int i = 0; i < 4; ++i) { v0[i] = silu_f(v0[i]); v1[i] = silu_f(v1[i]); } }
                    if constexpr (SQ) sq += (v0[0] * v0[0] + v0[1] * v0[1]) + (v0[2] * v0[2] + v0[3] * v0[3]) + (v1[0] * v1[0] + v1[1] * v1[1]) + (v1[2] * v1[2] + v1[3] * v1[3]);
                    NTST(rowp + bj * HALF, pack8f(v0, v1)); }
                if constexpr (SQ) { sq += __shfl_xor(sq, 16); sq += __shfl_xor(sq, 32); if (fq == 0) ss[(size_t)row * 8 + part] = sq; } }
    }
    __device__ __forceinline__ void operator()(const f32x4 (&acc)[2][2][4][2], const Unit& u, int wr, int wc, int fr, int fq) const {
#ifdef PROBE_P1K2
        if (u.dummy) return;
#endif
        const int row0 = u.pm * BM + wr * 64 + fr; const int pn = u.pn;
        if (pn == 9) {
            if (wc < 2) {
                float fqv[4];
#pragma unroll
                for (int i = 0; i < 4; ++i) fqv[i] = rope_inv_freq(16 * wc + 4 * fq + i);
                int pv[2][4];
#pragma unroll
                for (int ai = 0; ai < 2; ++ai)
#pragma unroll
                    for (int m = 0; m < 4; ++m) pv[ai][m] = pos[row0 + ai * HALF + m * 16];
#pragma unroll
                for (int ai = 0; ai < 2; ++ai)
#pragma unroll
                    for (int m = 0; m < 4; ++m) { const int row = row0 + ai * HALF + m * 16; const float pf = (float)pv[ai][m];
                        const f32x4 t1 = acc[ai][0][m][0], t2 = acc[ai][0][m][1]; f32x4 o1, o2;
#pragma unroll
                        for (int i = 0; i < 4; ++i) { float s, c; sincos_rad(pf * fqv[i], s, c); o1[i] = t1[i] * c - t2[i] * s; o2[i] = t1[i] * s + t2[i] * c; }
                        NTST(KR + (size_t)row * 64 + 32 * wc + 8 * fq, pack8f(o1, o2)); }
            }
            return;
        }
        if (pn == 2) {
            float sqv[2][4];
#pragma unroll
            for (int ai = 0; ai < 2; ++ai)
#pragma unroll
                for (int m = 0; m < 4; ++m) { float sq = 0.f;
#pragma unroll
                    for (int bj = 0; bj < 2; ++bj)
#pragma unroll
                        for (int n = 0; n < 2; ++n) { const f32x4 v = acc[ai][bj][m][n]; sq += (v[0] * v[0] + v[1] * v[1]) + (v[2] * v[2] + v[3] * v[3]); }
                    sq += __shfl_xor(sq, 16); sq += __shfl_xor(sq, 32); sqv[ai][m] = sq;
                    if (fq == 0) red[(ai * HALF + wr * 64 + m * 16 + fr) * 4 + wc] = sq; }
            asm volatile("s_waitcnt lgkmcnt(0)" ::: "memory"); __builtin_amdgcn_s_barrier(); asm volatile("" ::: "memory");
#pragma unroll
            for (int ai = 0; ai < 2; ++ai)
#pragma unroll
                for (int m = 0; m < 4; ++m) { const int row = row0 + ai * HALF + m * 16; const PG8_LAS f32x4* rp = (const PG8_LAS f32x4*)(red + (ai * HALF + wr * 64 + m * 16 + fr) * 4); const f32x4 t = *rp;
                    const float rinv = __builtin_amdgcn_rsqf(((t[0] + t[1]) + (t[2] + t[3])) * (1.0f / 256.0f) + 1e-6f);
                    bf16_t* rowp = XKV + (size_t)row * 256 + wc * 32 + 8 * fq;
#pragma unroll
                    for (int bj = 0; bj < 2; ++bj) NTST(rowp + bj * HALF, pack8f(acc[ai][bj][m][0] * rinv, acc[ai][bj][m][1] * rinv)); }
            asm volatile("s_waitcnt lgkmcnt(0)" ::: "memory"); __builtin_amdgcn_s_barrier(); asm volatile("" ::: "memory");
            return;
        }
        if (pn < 2) body<false, true>(acc, XQ, pn * 256, SSQ, pn * 4 + wc, row0, wc, fq);
        else if (pn < 5) body<!GA_SILU_IN_ATTN, false>(acc, GA, (pn - 3) * 256, nullptr, 0, row0, wc, fq);
        else if (pn < 7) body<false, false>(acc, U, (pn - 5) * 256, nullptr, 0, row0, wc, fq);
        else body<!GB_SILU_IN_POOL, false>(acc, GB, (pn - 7) * 256, nullptr, 0, row0, wc, fq);
    }
};

constexpr float QSCALE = 0.07216878364870323f * 1.4426950408889634f;
struct EpiQ {
    static constexpr bool PERM = true, AFTER_DRAIN = false, INIT_ACC = false, XRES = false, HAS_NARROW = false, KHOOK = false; static constexpr int KROT = 0;
    __device__ __forceinline__ bool narrow(const Unit&) const { return false; }
    __device__ __forceinline__ int nst(const Unit&) const { return 16; }
    bf16_t* Q; const int* pos;
    __device__ __forceinline__ void operator()(const f32x4 (&acc)[2][2][4][2], const Unit& u, int wr, int wc, int fr, int fq) const {
        const int row0 = u.pm * BM + wr * 64 + fr; const int pn = u.pn;
        if (pn < 2) {
#pragma unroll
            for (int ai = 0; ai < 2; ++ai)
#pragma unroll
                for (int m = 0; m < 4; ++m) { bf16_t* qrow = Q + (size_t)(row0 + ai * HALF + m * 16) * 768;
#pragma unroll
                    for (int bj = 0; bj < 2; ++bj) NTST(qrow + (2 * pn + bj) * 192 + 32 * wc + 8 * fq, pack8f(acc[ai][bj][m][0], acc[ai][bj][m][1])); }
            return;
        }
        float fqv[4];
#pragma unroll
        for (int i = 0; i < 4; ++i) fqv[i] = rope_inv_freq(16 * (wc & 1) + 4 * fq + i);
        int pv[2][4];
#pragma unroll
        for (int ai = 0; ai < 2; ++ai)
#pragma unroll
            for (int m = 0; m < 4; ++m) pv[ai][m] = pos[row0 + ai * HALF + m * 16];
#pragma unroll
        for (int ai = 0; ai < 2; ++ai)
#pragma unroll
            for (int m = 0; m < 4; ++m) { const int row = row0 + ai * HALF + m * 16; bf16_t* qrow = Q + (size_t)row * 768; const float pf = (float)pv[ai][m];
                float sn[4], cs[4];
#pragma unroll
                for (int i = 0; i < 4; ++i) sincos_rad(pf * fqv[i], sn[i], cs[i]);
#pragma unroll
                for (int bj = 0; bj < 2; ++bj) { const f32x4 t1 = acc[ai][bj][m][0], t2 = acc[ai][bj][m][1]; f32x4 o1, o2;
#pragma unroll
                    for (int i = 0; i < 4; ++i) { o1[i] = t1[i] * cs[i] - t2[i] * sn[i]; o2[i] = t1[i] * sn[i] + t2[i] * cs[i]; }
                    NTST(qrow + (2 * bj + (wc >> 1)) * 192 + 128 + 32 * (wc & 1) + 8 * fq, pack8f(o1, o2)); } }
    }
};
struct EpiKV {
    static constexpr bool PERM = true, AFTER_DRAIN = false, INIT_ACC = false, XRES = false, HAS_NARROW = false, KHOOK = false; static constexpr int KROT = 0;
    __device__ __forceinline__ bool narrow(const Unit&) const { return false; }
    __device__ __forceinline__ int nst(const Unit&) const { return 16; }
    bf16_t *KN, *VV;
    __device__ __forceinline__ void operator()(const f32x4 (&acc)[2][2][4][2], const Unit& u, int wr, int wc, int fr, int fq) const {
        const int row0 = u.pm * BM + wr * 64 + fr; const int pn = u.pn;
#pragma unroll
        for (int ai = 0; ai < 2; ++ai)
#pragma unroll
            for (int m = 0; m < 4; ++m) { const size_t o = (size_t)(row0 + ai * HALF + m * 16) * 512 + pn * 128 + 32 * wc + 8 * fq;
                NTST(KN + o, pack8f(acc[ai][0][m][0], acc[ai][0][m][1]));
                NTST(VV + o, pack8f(acc[ai][1][m][0], acc[ai][1][m][1])); }
    }
};
__device__ __forceinline__ void bstore16(u32x4 v, __amdgpu_buffer_rsrc_t r, int voff, int soff) { __builtin_amdgcn_raw_buffer_store_b128(v, r, voff + soff, 0, NT_AUX); }
struct EpiOutLnBar {
    static constexpr bool PERM = false, AFTER_DRAIN = true, INIT_ACC = true, XRES = false, HAS_NARROW = false, KHOOK = false; static constexpr int KROT = 0;
    static constexpr float eps_s = 1e-5f / 1.4142135623730951f;
    __device__ __forceinline__ bool narrow(const Unit&) const { return false; }
    __device__ __forceinline__ int nst(const Unit&) const { return 0; }
    const float* x; float* out; const float* lng; const float* lnb; float* stat; const XcdBarrier* bar;
    __device__ __forceinline__ void init_acc(f32x4 (&acc)[2][2][4][2], const Unit& u, int wr, int wc, int fr, int fq) const {
        const __amdgpu_buffer_rsrc_t rX = __builtin_amdgcn_make_buffer_rsrc((void*)x, 0, 65536u * 1024u * 4u, 0x00020000);
        const int vo = (fr * 1024 + wc * 32 + 4 * fq) * 4; const int so0 = ((u.pm * BM + wr * 64) * 1024 + u.pn * BM) * 4;
#pragma unroll
        for (int ai = 0; ai < 2; ++ai)
#pragma unroll
            for (int bj = 0; bj < 2; ++bj)
#pragma unroll
                for (int m = 0; m < 4; ++m)
#pragma unroll
                    for (int n = 0; n < 2; ++n) acc[ai][bj][m][n] = __builtin_bit_cast(f32x4, __builtin_amdgcn_raw_buffer_load_b128(rX, vo + (bj * HALF + n * 16) * 4, so0 + (ai * HALF + m * 16) * 4096, 0));
    }
    __device__ __forceinline__ void fused(f32x4 (&acc)[2][2][4][2], const Unit& u, int wr, int wc, int fr_, int fq_, PG8_LAS unsigned char* lds, int wid, int lane_) const {
        typedef float f32x2v __attribute__((ext_vector_type(2)));
        int lane = lane_; asm volatile("" : "+v"(lane));
        const int fr = lane & 15, fq = lane >> 4;
        PG8_LAS f32x2v* S = (PG8_LAS f32x2v*)(lds + 8192);
        const __amdgpu_buffer_rsrc_t rO = __builtin_amdgcn_make_buffer_rsrc((void*)out, 0, 65536u * 1024u * 4u, 0x00020000);
        const int vo = (fr * 1024 + wc * 32 + 4 * fq) * 4;
        const int so0 = ((u.pm * BM + wr * 64) * 1024 + u.pn * BM) * 4;
#pragma unroll
        for (int ai = 0; ai < 2; ++ai)
#pragma unroll
            for (int m = 0; m < 4; ++m) { float s = 0.f, q = 0.f;
#pragma unroll
                for (int bj = 0; bj < 2; ++bj)
#pragma unroll
                    for (int n = 0; n < 2; ++n) { const f32x4 v = acc[ai][bj][m][n]; s += (v[0] + v[1]) + (v[2] + v[3]); q += (v[0] * v[0] + v[1] * v[1]) + (v[2] * v[2] + v[3] * v[3]); }
                s += __shfl_xor(s, 16); s += __shfl_xor(s, 32); q += __shfl_xor(q, 16); q += __shfl_xor(q, 32);
                if (fq == 0) *(f32x2v*)(stat + ((size_t)(u.pm * BM + ai * HALF + wr * 64 + m * 16 + fr) * 16 + u.pn * 4 + wc) * 2) = (f32x2v){s, q}; }
        xcd_barrier(*bar);
        { const int row = wid * 64 + lane;
          if (row < 256) { const f32x4* p = (const f32x4*)(stat + (size_t)(u.pm * BM + row) * 32); float s = 0.f, q = 0.f;
#pragma unroll
              for (int k = 0; k < 8; ++k) { const f32x4 t = p[k]; s += t[0] + t[2]; q += t[1] + t[3]; }
              const float mean = s * (1.0f / 1024.0f); const float var = fmaxf(q * (1.0f / 1024.0f) - mean * mean, 0.f);
              S[row] = (f32x2v){mean, 1.0f / sqrtf(var + eps_s)}; } }
        asm volatile("s_waitcnt lgkmcnt(0)" ::: "memory"); __builtin_amdgcn_s_barrier(); asm volatile("" ::: "memory");
        const int col0 = u.pn * BM + wc * 32 + 4 * fq;
#pragma unroll
        for (int bj = 0; bj < 2; ++bj)
#pragma unroll
            for (int n = 0; n < 2; ++n) { const f32x4 gv = *(const f32x4*)(lng + col0 + bj * HALF + n * 16), bv = *(const f32x4*)(lnb + col0 + bj * HALF + n * 16);
#pragma unroll
                for (int ai = 0; ai < 2; ++ai)
#pragma unroll
                    for (int m = 0; m < 4; ++m) { const int r = ai * HALF + wr * 64 + m * 16 + fr; const f32x2v sr = S[r];
                        const f32x4 o = (acc[ai][bj][m][n] - sr.x) * sr.y * gv + bv;
                        bstore16(__builtin_bit_cast(u32x4, o), rO, vo + (bj * HALF + n * 16) * 4, so0 + (ai * HALF + m * 16) * 4096); } }
    }
};
#ifdef LN_POLL
#define LN_MARK 1u
#else
#define LN_MARK 0u
#endif
struct EpiOutLnPeer {
#ifdef FUSE34_KROT
    static constexpr bool KHOOK = true; static constexpr int KROT = 8;
#else
    static constexpr bool KHOOK = false; static constexpr int KROT = 0;
#endif
    __device__ __forceinline__ void khook(int t, const Unit& u) const {
#ifdef PROBE_P4K2
        if (u.dummy) return;
#endif
        if (t == 0) { if (threadIdx.x == 0) (void)__hip_atomic_fetch_add(pcnt + u.pm * 16, 1u, __ATOMIC_RELAXED, __HIP_MEMORY_SCOPE_AGENT); }
#ifdef XRES_TOUCH
        else if (t == XRES_TOUCH) {
            int tl = threadIdx.x; asm volatile("" : "+v"(tl)); const int wv = __builtin_amdgcn_readfirstlane(tl >> 6);
            const char* xb = (const char*)x + ((size_t)(u.pm * BM) * 1024 + (size_t)u.pn * BM) * 4;
#pragma unroll
            for (int j = 0; j < 4; ++j) { const int L = tl * 4 + j; __builtin_amdgcn_global_load_lds((const unsigned*)(xb + (size_t)(L >> 3) * 4096 + (L & 7) * 128), (PG8_LAS unsigned*)(tab + 4096 + wv * 256), 4, 0, 0); } }
#endif
        else if (t == 4) { if (__builtin_amdgcn_readfirstlane((int)threadIdx.x >> 6) == 0) { unsigned sp = 0u;
            while (__hip_atomic_load(pcnt + u.pm * 16, __ATOMIC_RELAXED, __HIP_MEMORY_SCOPE_AGENT) < 4u) { __builtin_amdgcn_s_sleep(1);
                if ((++sp & 1023u) == 0u && (sp > (1u << 22) || __hip_atomic_load(tmo, __ATOMIC_RELAXED, __HIP_MEMORY_SCOPE_AGENT) != 0u)) { __hip_atomic_store(tmo, 1u, __ATOMIC_RELAXED, __HIP_MEMORY_SCOPE_AGENT); break; } } } }
    }
    static constexpr bool PERM = false, AFTER_DRAIN = false, INIT_ACC = false, XRES = true, HAS_NARROW = false;
    __device__ __forceinline__ const char* xres_ptr() const { return (const char*)x; }
    static constexpr float eps_s = 1e-5f / 1.4142135623730951f;
    __device__ __forceinline__ bool narrow(const Unit&) const { return false; }
    __device__ __forceinline__ int nst(const Unit&) const { return 0; }
    const float* x; float* out; const float* lng; const float* lnb; float* stat; unsigned* cnt; unsigned* tmo; PG8_LAS unsigned char* tab; const XcdBarrier* bar; unsigned* pcnt;
    __device__ __forceinline__ void init_acc(f32x4 (&acc)[2][2][4][2], const Unit& u, int wr, int wc, int fr, int fq) const {
        const __amdgpu_buffer_rsrc_t rX = __builtin_amdgcn_make_buffer_rsrc((void*)x, 0, 65536u * 1024u * 4u, 0x00020000);
        const int vo = (fr * 1024 + wc * 32 + 4 * fq) * 4; const int so0 = ((u.pm * BM + wr * 64) * 1024 + u.pn * BM) * 4;
#pragma unroll
        for (int ai = 0; ai < 2; ++ai)
#pragma unroll
            for (int bj = 0; bj < 2; ++bj)
#pragma unroll
                for (int m = 0; m < 4; ++m)
#pragma unroll
                    for (int n = 0; n < 2; ++n) { acc[ai][bj][m][n] = __builtin_bit_cast(f32x4, __builtin_amdgcn_raw_buffer_load_b128(rX, vo + (bj * HALF + n * 16) * 4, so0 + (ai * HALF + m * 16) * 4096, 0));
#ifdef PROBE_X2
                        { f32x4 dup = __builtin_bit_cast(f32x4, __builtin_amdgcn_raw_buffer_load_b128(rX, vo + (bj * HALF + n * 16) * 4, so0 + (ai * HALF + m * 16) * 4096 + 1024 * 4096, 1)); asm volatile("" :: "v"(dup)); }
#endif
                    }
    }
    __device__ __forceinline__ void operator()(const f32x4 (&acc)[2][2][4][2], const Unit& u, int wr, int wc, int fr_, int fq_) const { run(acc, u, wr, wc, 0); }
    __device__ __forceinline__ void run(const f32x4 (&acc)[2][2][4][2], const Unit& u, int wr, int wc, int cbank) const {
        typedef float f32x2v __attribute__((ext_vector_type(2)));
        if (u.dummy) return;
        int tid = threadIdx.x; asm volatile("" : "+v"(tid));
        const int lane = tid & 63, fr = lane & 15, fq = lane >> 4;
        PG8_LAS f32x2v* S = (PG8_LAS f32x2v*)tab; PG8_LAS unsigned* flag = (PG8_LAS unsigned*)(tab + 2048);
#ifdef DBG_X2
        { const __amdgpu_buffer_rsrc_t rO2 = __builtin_amdgcn_make_buffer_rsrc((void*)out, 0, 65536u * 1024u * 4u, 0x00020000); const int vo2 = (fr * 1024 + wc * 32 + 4 * fq) * 4; const int so2 = ((u.pm * BM + wr * 64) * 1024 + u.pn * BM) * 4;
          _Pragma("unroll") for (int ai = 0; ai < 2; ++ai) _Pragma("unroll") for (int m = 0; m < 4; ++m) _Pragma("unroll") for (int bj = 0; bj < 2; ++bj) _Pragma("unroll") for (int n = 0; n < 2; ++n)
            bstore16(__builtin_bit_cast(u32x4, acc[ai][bj][m][n]), rO2, vo2 + (bj * HALF + n * 16) * 4, so2 + (ai * HALF + m * 16) * 4096);
          return; }
#endif
        const __amdgpu_buffer_rsrc_t rO = __builtin_amdgcn_make_buffer_rsrc((void*)out, 0, 65536u * 1024u * 4u, 0x00020000);
#if defined(PROBE_ST2B) || defined(PROBE_ST2C)
        const __amdgpu_buffer_rsrc_t rOB = __builtin_amdgcn_make_buffer_rsrc((void*)((char*)stat + (28u << 20)), 0, 65536u * 1024u * 4u, 0x00020000);
#endif
        const int vo = (fr * 1024 + wc * 32 + 4 * fq) * 4;
        const int so0 = ((u.pm * BM + wr * 64) * 1024 + u.pn * BM) * 4;
        f32x4 gvv[2][2], bvv[2][2];
        { const int col0 = u.pn * BM + wc * 32 + 4 * fq;
#pragma unroll
          for (int bj = 0; bj < 2; ++bj)
#pragma unroll
              for (int n = 0; n < 2; ++n) { gvv[bj][n] = *(const f32x4*)(lng + col0 + bj * HALF + n * 16); bvv[bj][n] = *(const f32x4*)(lnb + col0 + bj * HALF + n * 16); } }
#ifdef PROBE_STAT2
        _Pragma("unroll 1") for (int rep_ = 0; rep_ < 2; ++rep_) {
#else
        {
#endif
#pragma unroll
        for (int ai = 0; ai < 2; ++ai)
#pragma unroll
            for (int m = 0; m < 4; ++m) { float s = 0.f, q = 0.f;
#pragma unroll
                for (int bj = 0; bj < 2; ++bj)
#pragma unroll
                    for (int n = 0; n < 2; ++n) { const f32x4 v = acc[ai][bj][m][n]; s += (v[0] + v[1]) + (v[2] + v[3]); q += (v[0] * v[0] + v[1] * v[1]) + (v[2] * v[2] + v[3] * v[3]); }
                s += __shfl_xor(s, 16); s += __shfl_xor(s, 32); q += __shfl_xor(q, 16); q += __shfl_xor(q, 32);
                if (fq == 0) __hip_atomic_store((unsigned long long*)(stat + ((size_t)(u.pm * BM + ai * HALF + wr * 64 + m * 16 + fr) * 16 + u.pn * 4 + wc) * 2),
                                                ((unsigned long long)(__float_as_uint(q) | LN_MARK) << 32) | __float_as_uint(s), __ATOMIC_RELAXED, __HIP_MEMORY_SCOPE_AGENT); }
#ifndef LN_POLL
        asm volatile("s_waitcnt vmcnt(0)" ::: "memory");
#endif
        }
#ifdef LN_POLL
        if (tid == 0) flag[0] = 0u;
        if (tid < 256) { const unsigned long long* p = (const unsigned long long*)(stat + (size_t)(u.pm * BM + tid) * 32); float s = 0.f, q = 0.f; unsigned sp = 0u;
            for (;;) { unsigned long long w[16]; bool ok = true;
#pragma unroll
                for (int k = 0; k < 16; ++k) { w[k] = __hip_atomic_load(p + k, __ATOMIC_RELAXED, __HIP_MEMORY_SCOPE_AGENT); }
#pragma unroll
                for (int k = 0; k < 16; ++k) ok = ok && ((unsigned)(w[k] >> 32) != 0u);
                if (ok) { s = 0.f; q = 0.f;
#pragma unroll
                    for (int k = 0; k < 16; ++k) { s += __uint_as_float((unsigned)w[k]); q += __uint_as_float((unsigned)(w[k] >> 32)); }
                    break; }
                __builtin_amdgcn_s_sleep(1);
                if ((++sp & 255u) == 0u && (sp > (1u << 20) || __hip_atomic_load(tmo, __ATOMIC_RELAXED, __HIP_MEMORY_SCOPE_AGENT) != 0u)) { __hip_atomic_store(tmo, 1u, __ATOMIC_RELAXED, __HIP_MEMORY_SCOPE_AGENT); flag[0] = 1u; break; } }
            const float mean = s * (1.0f / 1024.0f); const float var = fmaxf(q * (1.0f / 1024.0f) - mean * mean, 0.f);
            S[tid] = (f32x2v){mean, 1.0f / sqrtf(var + eps_s)}; }
        asm volatile("s_waitcnt lgkmcnt(0)" ::: "memory"); __builtin_amdgcn_s_barrier(); asm volatile("" ::: "memory");
        const bool bad = flag[0] != 0u; const float qnan = __builtin_nanf("");
#else
        __builtin_amdgcn_s_barrier(); asm volatile("" ::: "memory");
#ifdef DBG_NOPEER
        if (tid == 0) flag[0] = 0u;
#else
        if (tid == 0) {
            unsigned* c = cnt + 64 * u.pm + cbank * (2 * 256 * 64);
            (void)__hip_atomic_fetch_add(c, 1u, __ATOMIC_RELAXED, __HIP_MEMORY_SCOPE_AGENT);
            unsigned sp = 0u, dead = 0u;
            while (__hip_atomic_load(c, __ATOMIC_RELAXED, __HIP_MEMORY_SCOPE_AGENT) < 4u) { __builtin_amdgcn_s_sleep(2);
                if ((++sp & 1023u) == 0u) { if (sp > (1u << 20) || __hip_atomic_load(tmo, __ATOMIC_RELAXED, __HIP_MEMORY_SCOPE_AGENT) != 0u) { __hip_atomic_store(tmo, 1u, __ATOMIC_RELAXED, __HIP_MEMORY_SCOPE_AGENT); dead = 1u; break; } } }
#ifdef PROBE_POLL2
            for (int k_ = 0; k_ < 8; ++k_) { if (__hip_atomic_load(c, __ATOMIC_RELAXED, __HIP_MEMORY_SCOPE_AGENT) < 4u) dead = 1u; }
#endif
            flag[0] = dead;
        }
#endif
        asm volatile("s_waitcnt lgkmcnt(0)" ::: "memory"); __builtin_amdgcn_s_barrier(); asm volatile("" ::: "memory");
#ifdef DBG_EXTRA_GRIDBAR
        xcd_barrier(*bar);
#endif
#ifdef PROBE_RD2
        _Pragma("unroll 1") for (int rep_ = 0; rep_ < 2; ++rep_)
#endif
#ifdef LN_SLOTS_WIDE
        { const __amdgpu_buffer_rsrc_t rS = __builtin_amdgcn_make_buffer_rsrc((void*)stat, 0, 65536u * 128u, 0x00020000);
          const int sv = (tid >> 1) * 128 + (tid & 1) * 64, ss = u.pm * BM * 128;
          const u32x4 w0 = __builtin_amdgcn_raw_buffer_load_b128(rS, sv + ss, 0, 16), w1 = __builtin_amdgcn_raw_buffer_load_b128(rS, sv + ss + 16, 0, 16),
                      w2 = __builtin_amdgcn_raw_buffer_load_b128(rS, sv + ss + 32, 0, 16), w3 = __builtin_amdgcn_raw_buffer_load_b128(rS, sv + ss + 48, 0, 16);
          float s = ((__uint_as_float(w0.x) + __uint_as_float(w0.z)) + (__uint_as_float(w1.x) + __uint_as_float(w1.z))) + ((__uint_as_float(w2.x) + __uint_as_float(w2.z)) + (__uint_as_float(w3.x) + __uint_as_float(w3.z)));
          float q = ((__uint_as_float(w0.y) + __uint_as_float(w0.w)) + (__uint_as_float(w1.y) + __uint_as_float(w1.w))) + ((__uint_as_float(w2.y) + __uint_as_float(w2.w)) + (__uint_as_float(w3.y) + __uint_as_float(w3.w)));
          s += __shfl_xor(s, 1); q += __shfl_xor(q, 1);
          if ((tid & 1) == 0) { const float mean = s * (1.0f / 1024.0f); const float var = fmaxf(q * (1.0f / 1024.0f) - mean * mean, 0.f);
              S[tid >> 1] = (f32x2v){mean, 1.0f / sqrtf(var + eps_s)}; } }
#else
        if (tid < 256) { const unsigned long long* p = (const unsigned long long*)(stat + (size_t)(u.pm * BM + tid) * 32); float s = 0.f, q = 0.f;
#pragma unroll
            for (int k = 0; k < 16; ++k) { const unsigned long long w = __hip_atomic_load(p + k, __ATOMIC_RELAXED, __HIP_MEMORY_SCOPE_AGENT); s += __uint_as_float((unsigned)w); q += __uint_as_float((unsigned)(w >> 32)); }
            const float mean = s * (1.0f / 1024.0f); const float var = fmaxf(q * (1.0f / 1024.0f) - mean * mean, 0.f);
            S[tid] = (f32x2v){mean, 1.0f / sqrtf(var + eps_s)}; }
#endif
        asm volatile("s_waitcnt lgkmcnt(0)" ::: "memory"); __builtin_amdgcn_s_barrier(); asm volatile("" ::: "memory");
        const bool bad = flag[0] != 0u; const float qnan = __builtin_nanf("");
#endif
#ifdef LN_ST128
        { const int voA = ((fr & 7) * 1024 + wc * 32 + 4 * fq + 16 * (fr >> 3)) * 4;
#pragma unroll
          for (int bj = 0; bj < 2; ++bj) { const f32x4 g0 = gvv[bj][0], g1 = gvv[bj][1], b0 = bvv[bj][0], b1 = bvv[bj][1];
#pragma unroll
            for (int ai = 0; ai < 2; ++ai)
#pragma unroll
                for (int m = 0; m < 4; ++m) { const int r = ai * HALF + wr * 64 + m * 16 + fr; const f32x2v sr = S[r];
                    f32x4 o0 = (acc[ai][bj][m][0] - sr.x) * sr.y * g0 + b0, o1 = (acc[ai][bj][m][1] - sr.x) * sr.y * g1 + b1;
                    if (bad) { o0 = (f32x4){qnan, qnan, qnan, qnan}; o1 = o0; }
                    u32x4 A, B; const u32x4 u0 = __builtin_bit_cast(u32x4, o0), u1 = __builtin_bit_cast(u32x4, o1);
#pragma unroll
                    for (int c = 0; c < 4; ++c) { A[c] = (unsigned)__builtin_amdgcn_update_dpp((int)u0[c], (int)u1[c], 0x128, 0xF, 0xC, false);
                                                  B[c] = (unsigned)__builtin_amdgcn_update_dpp((int)u1[c], (int)u0[c], 0x128, 0xF, 0x3, false); }
                    bstore16(A, rO, voA + (bj * HALF) * 4, so0 + (ai * HALF + m * 16) * 4096);
                    bstore16(B, rO, voA + (bj * HALF) * 4, so0 + (ai * HALF + m * 16 + 8) * 4096); } } }
#else
#ifdef PROBE_FIN2
        _Pragma("unroll 1") for (int rep_ = 0; rep_ < 2; ++rep_)
#endif
#pragma unroll
        for (int bj = 0; bj < 2; ++bj)
#pragma unroll
            for (int n = 0; n < 2; ++n) { const f32x4 gv = gvv[bj][n], bv = bvv[bj][n];
#pragma unroll
                for (int ai = 0; ai < 2; ++ai)
#pragma unroll
                    for (int m = 0; m < 4; ++m) { const int r = ai * HALF + wr * 64 + m * 16 + fr; const f32x2v sr = S[r];
#if defined(DBG_X3)
                        f32x4 o = acc[ai][bj][m][n];
#elif defined(DBG_X4)
                        f32x4 o = acc[ai][bj][m][n] + (sr.x - sr.x);
#elif defined(DBG_X5)
                        f32x4 o = acc[ai][bj][m][n] + ((__builtin_fabsf(sr.x) < 1e30f) ? 0.f : 100.f);
#elif defined(DBG_X6)
                        f32x4 o = acc[ai][bj][m][n] + ((__builtin_fabsf(sr.x) < 10.f) ? 0.f : 100.f);
#else
                        f32x4 o = (acc[ai][bj][m][n] - sr.x) * sr.y * gv + bv; if (bad) o = (f32x4){qnan, qnan, qnan, qnan};
#endif
                        bstore16(__builtin_bit_cast(u32x4, o), rO, vo + (bj * HALF + n * 16) * 4, so0 + (ai * HALF + m * 16) * 4096);
#ifdef PROBE_ST2
                        bstore16(__builtin_bit_cast(u32x4, o), rO, vo + (bj * HALF + n * 16) * 4, so0 + (ai * HALF + m * 16) * 4096);
#endif
#ifdef PROBE_ST2C
                        bstore16(__builtin_bit_cast(u32x4, o), rOB, (((fr & 7) * 1024 + wc * 32 + 4 * fq + 16 * (fr >> 3)) * 4) + (bj * HALF) * 4, so0 + (ai * HALF + m * 16 + 8 * n) * 4096);
#endif
#ifdef PROBE_ST2B
                        bstore16(__builtin_bit_cast(u32x4, o), rOB, vo + (bj * HALF + n * 16) * 4, so0 + (ai * HALF + m * 16) * 4096);
#endif
                    } }
#endif
        asm volatile("s_waitcnt lgkmcnt(0)" ::: "memory"); __builtin_amdgcn_s_barrier(); asm volatile("" ::: "memory");
    }
};
struct RoundOrder : StaticOrder {
    int round;
    __host__ __device__ void init(int M, int N, int G_, int c_, int round_) { StaticOrder::init(M, N, G_, c_); round = round_; }
    __host__ __device__ bool next(int i, Unit& u) const { if (i != 0) return false; return StaticOrder::next(round, u); }
};
struct DupOrder : StaticOrder {
    __host__ __device__ bool next(int i, Unit& u) const { const bool ok = StaticOrder::next(i >> 1, u); u.dummy = (i & 1) ? 0 : 1; return ok; }
};
struct RotOrder : StaticOrder {
    __host__ __device__ bool next(int i, Unit& u) const { const int s = (i == 2) ? 8 : (i == 4) ? 16 : (i == 7) ? 24 : 0; StaticOrder t = *this; t.c = (c & 7) | ((((c >> 3) + s) & 31) << 3); return t.next(i, u); }
};
struct AbOrder {
    static constexpr bool SINGLE = false;
    int c, nr;
    __device__ void init(int, int N, int, int c_) { c = c_; nr = N / BM; asm volatile("" : "+s"(nr)); }
    __device__ bool next(int i, Unit& u) const { if (i >= nr) return false; const int xcd = c & 7, k = c >> 3, grp = k & 1, j = k >> 1;
        u.pm = 8 * (4 * xcd + (j >> 2)) + 4 * grp + i; u.pn = j & 3; u.dummy = 0; return true; }
    __device__ __forceinline__ void a_ready(const Unit&) const {}
    __device__ __forceinline__ void done(const Unit&) const {}
};
struct OneOrder {
#ifdef ONE_TRIM
    static constexpr bool SINGLE = true;
#else
    static constexpr bool SINGLE = false;
#endif
    int pm, pn, n1, dum;
    __device__ void init(int pm_, int pn_, int dum_ = 0) { pm = pm_; pn = pn_; n1 = 1; dum = dum_; asm volatile("" : "+s"(n1)); }
    __device__ bool next(int i, Unit& u) const { if (i >= n1) return false; u.pm = pm; u.pn = pn; u.dummy = dum; return true; }
    __device__ __forceinline__ void a_ready(const Unit&) const {}
    __device__ __forceinline__ void done(const Unit&) const {}
};
struct NfOrder {
    static constexpr bool SINGLE = false;
    int c, nr;
    __device__ void init(int, int N, int, int c_) { c = c_; nr = N / BM; asm volatile("" : "+s"(nr)); }
    __device__ bool next(int i, Unit& u) const { if (i >= nr) return false; const int xcd = c & 7, k = c >> 3, cls = k & 1, cc = k >> 1, base = 32 * xcd + 16 * cls;
        const bool nar = cls ? (i == 0) : (i == nr - 1); const int sl = cls ? i - 1 : i;
        if (nar) { u.pm = base + cc; u.pn = nr - 1; }
        else { const int j = 16 * sl + cc, grp = j / 36, w = j - 36 * grp; u.pm = base + 4 * grp + (w & 3); u.pn = w >> 2; }
        u.dummy = 0; return true; }
    __device__ __forceinline__ void a_ready(const Unit&) const {}
    __device__ __forceinline__ void done(const Unit&) const {}
};
struct RevOrder : StaticOrder {
    __host__ __device__ bool next(int i, Unit& u) const { const bool ok = StaticOrder::next(i, u); u.pm = (u.pm & ~31) | (31 - (u.pm & 31)); return ok; }
};
template <class Epi, class Sched, bool ALIGN_EPI = false, bool SP2 = false>
__device__ __forceinline__ void gemm_phase(PG8_LAS unsigned char* lds, const Gemm g, const Sched& S, const Epi& E) {
    int tid_ = threadIdx.x; asm volatile("" : "+v"(tid_));
    const int tid = tid_, wid = __builtin_amdgcn_readfirstlane(tid >> 6), lane = tid & 63, wr = wid >> 2, wc = wid & 3, fr = lane & 15, fq = lane >> 4;
    const int K = g.K, nt = K / BK;
    unsigned voffA[2], voffB[2];
#pragma unroll
    for (int i = 0; i < 2; ++i) { int R, C; stage_rc(tid * 16 + i * 8192, R, C); const int Rb = Epi::PERM ? ((R & ~31) + perm32(R & 31)) : R;
        voffA[i] = (unsigned)(R * K + C) * 2u; voffB[i] = (unsigned)(Rb * K + C) * 2u; }
    const size_t kstep = (size_t)(BK * 2);
    const size_t hstep = (size_t)HALF * K * 2;
    const size_t tstep = 2 * hstep;
    const unsigned ldsw = (unsigned)wid * 1024u;
    const int aoff = lds_byte(wr * 64 + fr, fq * 8), boff = lds_byte(wc * 32 + fr, fq * 8);
#define PG8_SA(b, h) (((b) * 2 + (h)) * HTB)
#define PG8_SB(b, h) ((4 + (b) * 2 + (h)) * HTB)
#define PG8_STAGE(bufoff, gbase, voff) do { _Pragma("unroll") for (int _i = 0; _i < 2; ++_i) \
        __builtin_amdgcn_global_load_lds((const unsigned*)((const char*)(gbase) + (voff)[_i]), (PG8_LAS unsigned*)(lds + (bufoff) + ldsw + _i * 8192), 16, 0, 0); } while (0)
#define PG8_STAGE_X(bufoff, gsb) do { int tl_ = tid; asm volatile("" : "+v"(tl_)); const unsigned vox0 = (unsigned)((((tl_ & 15) * 1024) + wc * 32 + 4 * ((tl_ & 63) >> 4)) * 4), vox1 = vox0 + 64u; \
        __builtin_amdgcn_global_load_lds((const unsigned*)((gsb) + vox0), (PG8_LAS unsigned*)(lds + (bufoff) + ldsw), 16, 0, RDX_AUX); \
        __builtin_amdgcn_global_load_lds((const unsigned*)((gsb) + vox1), (PG8_LAS unsigned*)(lds + (bufoff) + ldsw + 8192), 16, 0, RDX_AUX); } while (0)
#define PG8_XRD(dst, bufoff) do { dst[0] = *(const PG8_LAS f32x4*)(lds + (bufoff) + ldsw + lane * 16); dst[1] = *(const PG8_LAS f32x4*)(lds + (bufoff) + ldsw + 8192 + lane * 16); } while (0)
#define PG8_LDA(dst, b, h) do { _Pragma("unroll") for (int m = 0; m < 4; ++m) _Pragma("unroll") for (int k = 0; k < 2; ++k) dst[m][k] = *(const PG8_LAS bf16x8*)(lds + PG8_SA(b, h) + aoff + m * 2048 + k * 1024); } while (0)
#define PG8_LDB(dst, b, h) do { _Pragma("unroll") for (int n = 0; n < 2; ++n) _Pragma("unroll") for (int k = 0; k < 2; ++k) dst[n][k] = *(const PG8_LAS bf16x8*)(lds + PG8_SB(b, h) + boff + n * 2048 + k * 1024); } while (0)
#define PG8_MMA(ai, bj, At, Bt) do { __builtin_amdgcn_s_setprio(1); _Pragma("unroll") for (int m = 0; m < 4; ++m) _Pragma("unroll") for (int n = 0; n < 2; ++n) _Pragma("unroll") for (int k = 0; k < 2; ++k) \
        acc[ai][bj][m][n] = __builtin_amdgcn_mfma_f32_16x16x32_bf16(Bt[n][k], At[m][k], acc[ai][bj][m][n], 0, 0, 0); __builtin_amdgcn_s_setprio(0); } while (0)
#define PG8_WAIT_V(n) asm volatile("s_waitcnt vmcnt(" #n ")" ::: "memory")
#define PG8_WAIT_L(n) asm volatile("s_waitcnt lgkmcnt(" #n ")" ::: "memory")
#define PG8_BAR __builtin_amdgcn_s_barrier()
#define PG8_SCHED __builtin_amdgcn_sched_barrier(0)
    constexpr int KR = Epi::KROT;
#define PG8_KOFF(i) ((size_t)(KR ? (((i) + KR) & (2 * KR - 1)) : (i)) * kstep)
    Unit cur, nxt; int ui = 0;
    if (!S.next(0, cur)) return;
    f32x4 acc[2][2][4][2];
    if constexpr (Epi::INIT_ACC) E.init_acc(acc, cur, wr, wc, fr, fq);
    else {
#pragma unroll
    for (int a = 0; a < 2; ++a)
#pragma unroll
        for (int b = 0; b < 2; ++b)
#pragma unroll
            for (int m = 0; m < 4; ++m)
#pragma unroll
                for (int n = 0; n < 2; ++n) acc[a][b][m][n] = (f32x4){0.f, 0.f, 0.f, 0.f};
    }
    bf16x8 At[4][2], B0[2][2], B1[2][2];
    const char* cA = (const char*)g.A + (size_t)cur.pm * tstep; const char* cB = (const char*)g.Bt + (size_t)cur.pn * tstep;
    S.a_ready(cur);
    const char* pA0 = cA + PG8_KOFF(0); const char* pB0 = cB + PG8_KOFF(0); const char* pA1 = cA + PG8_KOFF(1); const char* pB1 = cB + PG8_KOFF(1);
    if constexpr (KR != 0) asm volatile("" : "+s"(pA0), "+s"(pB0), "+s"(pA1), "+s"(pB1));
    if constexpr (SP2) {
        PG8_STAGE(PG8_SB(0, 0), pB0, voffB); PG8_STAGE(PG8_SB(0, 1), pB0 + hstep, voffB); PG8_STAGE(PG8_SA(0, 0), pA0, voffA); PG8_STAGE(PG8_SA(0, 1), pA0 + hstep, voffA);
        if (wr == 1) PG8_BAR;
        PG8_WAIT_V(2); PG8_BAR;
        PG8_STAGE(PG8_SB(1, 0), pB1, voffB); PG8_STAGE(PG8_SA(1, 0), pA1, voffA); PG8_STAGE(PG8_SB(1, 1), pB1 + hstep, voffB);
        PG8_WAIT_V(6); PG8_BAR;
    } else {
        PG8_STAGE(PG8_SB(0, 0), pB0, voffB); PG8_STAGE(PG8_SA(0, 0), pA0, voffA); PG8_STAGE(PG8_SB(0, 1), pB0 + hstep, voffB); PG8_STAGE(PG8_SA(0, 1), pA0 + hstep, voffA);
        if (wr == 1) PG8_BAR;
        PG8_WAIT_V(4); PG8_BAR;
        PG8_STAGE(PG8_SB(1, 0), pB1, voffB); PG8_STAGE(PG8_SA(1, 0), pA1, voffA); PG8_STAGE(PG8_SB(1, 1), pB1 + hstep, voffB);
        PG8_WAIT_V(6); PG8_BAR;
    }
    int pend = 0;
    for (;;) {
        const bool has_next = S.next(ui + 1, nxt);
        const char* xs = nullptr; if constexpr (Epi::XRES) xs = E.xres_ptr() + ((size_t)(cur.pm * BM + wr * 64) * 1024 + (size_t)cur.pn * BM) * 4;
        constexpr size_t XM = 16 * 4096, XC = 128 * 4, XR = 128 * 4096;
        const bool nar = E.narrow(cur);
        const char* nA = has_next ? (const char*)g.A + (size_t)nxt.pm * tstep : cA; const char* nB = has_next ? (const char*)g.Bt + (size_t)nxt.pn * tstep : cB;
        const char* nA0 = nA + PG8_KOFF(0); const char* nB0 = nB + PG8_KOFF(0);
        if constexpr (KR != 0) asm volatile("" : "+s"(nA0), "+s"(nB0));
#define PG8_PAIR(NARROW, XLAST) do { \
            const bool last = (t == nt - 2); \
            if constexpr (Epi::KHOOK) E.khook(t, cur); \
            const char* a1 = cA + PG8_KOFF(t + 1); \
            const char* a2 = last ? nA0 : cA + PG8_KOFF(t + 2); const char* b2 = last ? nB0 : cB + PG8_KOFF(t + 2); \
            const char* a3 = a2 + kstep; const char* b3 = b2 + kstep; \
            if (!Epi::XRES && last && has_next) S.a_ready(nxt); \
              \
            PG8_LDB(B0, 0, 0); PG8_LDB(B1, 0, 1); PG8_SCHED; PG8_LDA(At, 0, 0); PG8_STAGE(PG8_SA(1, 1), a1 + hstep, voffA); \
            PG8_WAIT_V(8); PG8_WAIT_L(0); PG8_BAR; PG8_MMA(0, 0, At, B0); if constexpr (!(NARROW)) PG8_MMA(0, 1, At, B1); PG8_BAR; PG8_SCHED; \
              \
            PG8_LDA(At, 0, 1); \
            if constexpr (XLAST) { PG8_STAGE_X(PG8_SB(0, 0), xs + 2 * XM); PG8_STAGE_X(PG8_SB(0, 1), xs + 3 * XM); PG8_STAGE_X(PG8_SA(0, 0), xs); } \
            else { PG8_STAGE(PG8_SB(0, 0), b2, voffB); PG8_STAGE(PG8_SB(0, 1), b2 + hstep, voffB); PG8_STAGE(PG8_SA(0, 0), a2, voffA); } \
            PG8_WAIT_V(8); PG8_WAIT_L(0); PG8_BAR; PG8_MMA(1, 0, At, B0); if constexpr (!(NARROW)) PG8_MMA(1, 1, At, B1); PG8_BAR; PG8_SCHED; \
              \
            PG8_LDB(B0, 1, 0); PG8_LDB(B1, 1, 1); PG8_SCHED; PG8_LDA(At, 1, 0); \
            if constexpr (XLAST) PG8_STAGE_X(PG8_SA(0, 1), xs + XM); else PG8_STAGE(PG8_SA(0, 1), a2 + hstep, voffA); \
            PG8_WAIT_V(8); PG8_WAIT_L(0); PG8_BAR; PG8_MMA(0, 0, At, B0); if constexpr (!(NARROW)) PG8_MMA(0, 1, At, B1); PG8_BAR; PG8_SCHED; \
              \
            PG8_LDA(At, 1, 1); \
            if constexpr (XLAST) { PG8_STAGE_X(PG8_SB(1, 0), xs + XC + 2 * XM); PG8_STAGE_X(PG8_SB(1, 1), xs + XC + 3 * XM); PG8_STAGE_X(PG8_SA(1, 0), xs + XC); } \
            else { PG8_STAGE(PG8_SB(1, 0), b3, voffB); PG8_STAGE(PG8_SB(1, 1), b3 + hstep, voffB); PG8_STAGE(PG8_SA(1, 0), a3, voffA); } \
            PG8_WAIT_V(8); PG8_WAIT_L(0); PG8_BAR; PG8_MMA(1, 0, At, B0); if constexpr (!(NARROW)) PG8_MMA(1, 1, At, B1); PG8_BAR; PG8_SCHED; } while (0)
        static_assert(SP2, "this build keeps only the two-super-phase K-loop");
        if (Epi::HAS_NARROW && nar) {
#pragma unroll 1
            for (int t = 0; t < nt; t += 2) PG8_PAIR(true, false);
        } else if constexpr (Epi::XRES) {
#pragma unroll 1
            for (int t = 0; t < nt - 2; t += 2) PG8_PAIR(false, false);
            { const int t = nt - 2; PG8_PAIR(false, true); }
        } else {
#pragma unroll 1
            for (int t = 0; t < nt; t += 2) PG8_PAIR(false, false);
        }
#undef PG8_PAIR
        if constexpr (Epi::XRES && SP2) {
            f32x4 xr0[2], xr1[2], xr2[2];
#define PG8_XADD(ai, bj, m, src) do { acc[ai][bj][m][0] = acc[ai][bj][m][0] + src[0]; acc[ai][bj][m][1] = acc[ai][bj][m][1] + src[1]; \
                asm volatile("" : "+v"(acc[ai][bj][m][0]), "+v"(acc[ai][bj][m][1])); } while (0)
            PG8_XRD(xr0, PG8_SB(0, 0)); PG8_XRD(xr1, PG8_SB(0, 1)); PG8_XRD(xr2, PG8_SA(0, 0)); PG8_STAGE_X(PG8_SA(1, 1), xs + XC + XM);
            PG8_WAIT_V(8); PG8_WAIT_L(0); PG8_BAR; PG8_XADD(0, 0, 2, xr0); PG8_XADD(0, 0, 3, xr1); PG8_XADD(0, 0, 0, xr2); PG8_BAR; PG8_SCHED;
            PG8_XRD(xr0, PG8_SA(0, 1)); PG8_STAGE_X(PG8_SB(0, 0), xs + XR + 2 * XM); PG8_STAGE_X(PG8_SB(0, 1), xs + XR + 3 * XM); PG8_STAGE_X(PG8_SA(0, 0), xs + XR);
            PG8_WAIT_V(8); PG8_WAIT_L(0); PG8_BAR; PG8_XADD(0, 0, 1, xr0); PG8_BAR; PG8_SCHED;
            PG8_XRD(xr0, PG8_SB(1, 0)); PG8_XRD(xr1, PG8_SB(1, 1)); PG8_XRD(xr2, PG8_SA(1, 0)); PG8_STAGE_X(PG8_SA(0, 1), xs + XR + XM);
            PG8_WAIT_V(8); PG8_WAIT_L(0); PG8_BAR; PG8_XADD(0, 1, 2, xr0); PG8_XADD(0, 1, 3, xr1); PG8_XADD(0, 1, 0, xr2); PG8_BAR; PG8_SCHED;
            PG8_XRD(xr0, PG8_SA(1, 1)); PG8_STAGE_X(PG8_SB(1, 0), xs + XR + XC + 2 * XM); PG8_STAGE_X(PG8_SB(1, 1), xs + XR + XC + 3 * XM); PG8_STAGE_X(PG8_SA(1, 0), xs + XR + XC);
            PG8_WAIT_V(8); PG8_WAIT_L(0); PG8_BAR; PG8_XADD(0, 1, 1, xr0); PG8_BAR; PG8_SCHED;
            if (has_next) S.a_ready(nxt);
            PG8_XRD(xr0, PG8_SB(0, 0)); PG8_XRD(xr1, PG8_SB(0, 1)); PG8_XRD(xr2, PG8_SA(0, 0)); PG8_STAGE_X(PG8_SA(1, 1), xs + XR + XC + XM);
            PG8_WAIT_V(8); PG8_WAIT_L(0); PG8_BAR; PG8_XADD(1, 0, 2, xr0); PG8_XADD(1, 0, 3, xr1); PG8_XADD(1, 0, 0, xr2); PG8_BAR; PG8_SCHED;
            if constexpr (Sched::SINGLE) {
            PG8_XRD(xr0, PG8_SA(0, 1));
            PG8_WAIT_V(2); PG8_WAIT_L(0); PG8_BAR; PG8_XADD(1, 0, 1, xr0); PG8_BAR; PG8_SCHED;
            PG8_XRD(xr0, PG8_SB(1, 0)); PG8_XRD(xr1, PG8_SB(1, 1)); PG8_XRD(xr2, PG8_SA(1, 0));
            PG8_WAIT_V(0); PG8_WAIT_L(0); PG8_BAR; PG8_XADD(1, 1, 2, xr0); PG8_XADD(1, 1, 3, xr1); PG8_XADD(1, 1, 0, xr2); PG8_BAR; PG8_SCHED;
            PG8_XRD(xr0, PG8_SA(1, 1));
            PG8_WAIT_L(0); PG8_BAR; PG8_XADD(1, 1, 1, xr0); PG8_BAR; PG8_SCHED;
            } else {
            PG8_XRD(xr0, PG8_SA(0, 1)); PG8_STAGE(PG8_SB(0, 0), nB0, voffB); PG8_STAGE(PG8_SB(0, 1), nB0 + hstep, voffB); PG8_STAGE(PG8_SA(0, 0), nA0, voffA);
            PG8_WAIT_V(8); PG8_WAIT_L(0); PG8_BAR; PG8_XADD(1, 0, 1, xr0); PG8_BAR; PG8_SCHED;
            PG8_XRD(xr0, PG8_SB(1, 0)); PG8_XRD(xr1, PG8_SB(1, 1)); PG8_XRD(xr2, PG8_SA(1, 0)); PG8_STAGE(PG8_SA(0, 1), nA0 + hstep, voffA);
            PG8_WAIT_V(8); PG8_WAIT_L(0); PG8_BAR; PG8_XADD(1, 1, 2, xr0); PG8_XADD(1, 1, 3, xr1); PG8_XADD(1, 1, 0, xr2); PG8_BAR; PG8_SCHED;
            PG8_XRD(xr0, PG8_SA(1, 1)); PG8_STAGE(PG8_SB(1, 0), nB0 + kstep, voffB); PG8_STAGE(PG8_SB(1, 1), nB0 + hstep + kstep, voffB); PG8_STAGE(PG8_SA(1, 0), nA0 + kstep, voffA);
            PG8_WAIT_V(8); PG8_WAIT_L(0); PG8_BAR; PG8_XADD(1, 1, 1, xr0); PG8_BAR; PG8_SCHED;
            }
#undef PG8_XADD
        }
        if constexpr (ALIGN_EPI) { if (wr == 0) PG8_BAR; }
        if constexpr (!Epi::AFTER_DRAIN) { E(acc, cur, wr, wc, fr, fq);
#ifdef PROBE_E2
            if constexpr (Epi::INIT_ACC) { asm volatile("" ::: "memory"); E.run(acc, cur, wr, wc, 1); }
#endif
#ifdef PROBE_EPI2
            if constexpr (!Epi::INIT_ACC && !Epi::XRES && (PROBE_EPI2 == 3 || Epi::HAS_NARROW == (PROBE_EPI2 == 1))) { asm volatile("" ::: "memory"); E(acc, cur, wr, wc, fr, fq); }
#endif
            S.done(cur); pend = E.nst(cur); }
        if (!has_next) break;
        if constexpr (Epi::INIT_ACC) E.init_acc(acc, nxt, wr, wc, fr, fq);
        else {
#pragma unroll
        for (int a = 0; a < 2; ++a)
#pragma unroll
            for (int b = 0; b < 2; ++b)
#pragma unroll
                for (int m = 0; m < 4; ++m)
#pragma unroll
                    for (int n = 0; n < 2; ++n) acc[a][b][m][n] = (f32x4){0.f, 0.f, 0.f, 0.f};
        }
        cur = nxt; cA = nA; cB = nB; ++ui;
        if constexpr (ALIGN_EPI) { if (wr == 1) PG8_BAR; }
    }
    if constexpr (!Sched::SINGLE) PG8_WAIT_V(0);
    if constexpr (!ALIGN_EPI) { if (wr == 0) PG8_BAR; }
    PG8_BAR;
    if constexpr (Epi::AFTER_DRAIN) { E.fused(acc, cur, wr, wc, fr, fq, lds, wid, lane); S.done(cur); }
#undef PG8_SA
#undef PG8_SB
#undef PG8_STAGE
#undef PG8_KOFF
#undef PG8_STAGE_X
#undef PG8_XRD
#undef PG8_LDA
#undef PG8_LDB
#undef PG8_MMA
#undef PG8_WAIT_V
#undef PG8_WAIT_L
#undef PG8_BAR
#undef PG8_SCHED
}
}
#ifndef PG8_SP2
#define PG8_SP2 true
#endif
#ifndef PG8_ALIGN
#define PG8_ALIGN true
#endif
#ifdef PROBE_P1K2
#define P1_ORDER pg8::DupOrder
#elif defined(P1_ROT)
#define P1_ORDER pg8::RotOrder
#elif defined(P1_NF)
#define P1_ORDER pg8::NfOrder
#else
#define P1_ORDER pg8::StaticOrder
#endif
#ifdef P2_REV
#define P2_ORDER pg8::RevOrder
#define P2_PM(pm) (((pm) & ~31) | (31 - ((pm) & 31)))
#else
#define P2_ORDER pg8::StaticOrder
#define P2_PM(pm) (pm)
#endif
namespace attn {
#define ATT_LAS __attribute__((address_space(3)))
typedef unsigned short bf16_t;
typedef short bf16x8 __attribute__((ext_vector_type(8)));
typedef short s16x4 __attribute__((ext_vector_type(4)));
typedef float f32x16 __attribute__((ext_vector_type(16)));
typedef float f32x4 __attribute__((ext_vector_type(4)));
typedef unsigned u32x4 __attribute__((ext_vector_type(4)));
typedef int i32x4 __attribute__((ext_vector_type(4)));
typedef ATT_LAS char* lptr;
constexpr int NW = 8, QBLK = 32, QB = 256, KVBLK = 64, SEQ = 2048;
constexpr int SHM_V = 16384, KROW = 400, SHM_K = 64 * KROW, QRROW = 272, SHM_QR = 32 * QRROW, NQREG = 4;
constexpr int LDS_V = 0, LDS_K = 2 * SHM_V, LDS_QR = LDS_K + 2 * SHM_K, LDS_WS = LDS_QR + NW * SHM_QR, LDS_BYTES = LDS_WS + NW * 256;
constexpr int LDS_MP = LDS_BYTES;
constexpr float THR = 8.f;
#define SBAR() __builtin_amdgcn_sched_barrier(0)
__device__ __forceinline__ int v_st(int k, int c) { const int kk = (k & ~0xC) | ((k & 4) << 1) | ((k & 8) >> 1); return ((kk >> 3) * 4 + (c >> 5)) * 512 + ((kk & 7) * 32 + (c & 31)) * 2; }
__device__ __forceinline__ int v_rd_base(int lane) { return ((lane & 3) << 3) | (((lane >> 2) & 3) << 6) | (((lane >> 4) & 1) << 5) | (((lane >> 5) & 1) << 8); }
constexpr int v_rd_off(int d0, int ks, int half) { return d0 * 512 + ks * 4096 + half * 2048; }
__device__ __forceinline__ int crow(int r, int hi) { return (r & 3) + 8 * (r >> 2) + 4 * hi; }
typedef float f32x2_t __attribute__((ext_vector_type(2))); typedef __bf16 bf16x2_t __attribute__((ext_vector_type(2)));
__device__ __forceinline__ unsigned cvtpk(float lo, float hi) { f32x2_t v = {lo, hi}; bf16x2_t b = __builtin_convertvector(v, bf16x2_t); return __builtin_bit_cast(unsigned, b); }
typedef short v4i16_t __attribute__((ext_vector_type(4)));
__device__ __forceinline__ s16x4 vtr(lptr p) { return __builtin_bit_cast(s16x4, __builtin_amdgcn_ds_read_tr16_b64_v4i16((ATT_LAS v4i16_t*)p)); }

__device__ __forceinline__ void partialSM(f32x16& p0, f32x16& p1, float& m_reg, float& alpha, const float rq  ) {
    float pmax = p0[0];
#pragma unroll
    for (int r = 1; r < 16; ++r) pmax = fmaxf(pmax, p0[r]);
#pragma unroll
    for (int r = 0; r < 16; ++r) pmax = fmaxf(pmax, p1[r]);
    { auto rr = __builtin_amdgcn_permlane32_swap(__float_as_uint(pmax), __float_as_uint(pmax), false, false);
      pmax = fmaxf(__uint_as_float(rr[0]), __uint_as_float(rr[1])) * rq; }
    float mn;
    if (__builtin_expect(__all((pmax - m_reg) <= THR), 1)) { mn = m_reg; alpha = 1.f; }
    else { mn = fmaxf(m_reg, pmax); alpha = __builtin_amdgcn_exp2f(m_reg - mn); m_reg = mn; }
#pragma unroll
    for (int r = 0; r < 16; ++r) { p0[r] = __builtin_fmaf(p0[r], rq, -mn); p1[r] = __builtin_fmaf(p1[r], rq, -mn); }
#pragma unroll
    for (int r = 0; r < 16; ++r) p0[r] = __builtin_amdgcn_exp2f(p0[r]);
}
__device__ __forceinline__ void finishSM(f32x16& p0, f32x16& p1, float alpha, float& l_reg, bf16x8& pa0, bf16x8& pa1, bf16x8& pa2, bf16x8& pa3) {
#pragma unroll
    for (int r = 0; r < 16; ++r) p1[r] = __builtin_amdgcn_exp2f(p1[r]);
    float ps = 0.f;
#pragma unroll
    for (int r = 0; r < 16; ++r) ps += p0[r];
#pragma unroll
    for (int r = 0; r < 16; ++r) ps += p1[r];
    { auto rr = __builtin_amdgcn_permlane32_swap(__float_as_uint(ps), __float_as_uint(ps), false, false);
      ps = __uint_as_float(rr[0]) + __uint_as_float(rr[1]); }
    l_reg = l_reg * alpha + ps;
#define PK4(P, B_, OUT) do { unsigned a0 = cvtpk(P[B_+0], P[B_+1]), a1 = cvtpk(P[B_+2], P[B_+3]);                          \
        unsigned b0 = cvtpk(P[B_+4], P[B_+5]), b1 = cvtpk(P[B_+6], P[B_+7]);                                             \
        auto r0 = __builtin_amdgcn_permlane32_swap(a0, b0, false, false); auto r1 = __builtin_amdgcn_permlane32_swap(a1, b1, false, false); \
        u32x4 w = {r0[0], r1[0], r0[1], r1[1]}; OUT = __builtin_bit_cast(bf16x8, w); } while (0)
    PK4(p0, 0, pa0); PK4(p0, 8, pa1); PK4(p1, 0, pa2); PK4(p1, 8, pa3);
#undef PK4
}
template <int KB>
__device__ __forceinline__ void qkt(f32x16& p0, f32x16& p1, lptr kbase, lptr qrb, const bf16x8* qr) {
    p0 = f32x16{}; p1 = f32x16{};
    lptr a = kbase + KB * SHM_K;
#pragma unroll
    for (int d0 = 0; d0 < 12; ++d0) {
        const bf16x8 b0 = *(const ATT_LAS bf16x8*)(a + d0 * 32);
        const bf16x8 b1 = *(const ATT_LAS bf16x8*)(a + d0 * 32 + 32 * KROW);
        bf16x8 q; if (d0 < NQREG) q = qr[d0]; else q = *(const ATT_LAS bf16x8*)(qrb + (d0 - NQREG) * 32);
        p0 = __builtin_amdgcn_mfma_f32_32x32x16_bf16(b0, q, p0, 0, 0, 0);
        p1 = __builtin_amdgcn_mfma_f32_32x32x16_bf16(b1, q, p1, 0, 0, 0);
    }
}
template <int KB>
__device__ __forceinline__ void qkt_fsm(f32x16& p0, f32x16& p1, lptr kbase, lptr qrb, const bf16x8* qr,
                                        f32x16& y0, f32x16& y1, float alpha, float& l_reg, bf16x8& pa0, bf16x8& pa1, bf16x8& pa2, bf16x8& pa3) {
    p0 = f32x16{}; p1 = f32x16{};
    lptr a = kbase + KB * SHM_K;
    float ps = 0.f;
    bf16x8 kA0, kA1, qA, kB0, kB1, qB, kC0, kC1, qC;
#define QK_LOAD(d0, S) do { k##S##0 = *(const ATT_LAS bf16x8*)(a + (d0) * 32); k##S##1 = *(const ATT_LAS bf16x8*)(a + (d0) * 32 + 32 * KROW); \
        if ((d0) >= NQREG) q##S = *(const ATT_LAS bf16x8*)(qrb + ((d0) - NQREG) * 32); } while (0)
#define QK_MMA(d0, S) do { const bf16x8 q_ = ((d0) < NQREG) ? qr[(d0) < NQREG ? (d0) : 0] : q##S; \
        p0 = __builtin_amdgcn_mfma_f32_32x32x16_bf16(k##S##0, q_, p0, 0, 0, 0); p1 = __builtin_amdgcn_mfma_f32_32x32x16_bf16(k##S##1, q_, p1, 0, 0, 0); } while (0)
#define PK4(P, B_, OUT) do { unsigned a0 = cvtpk(P[B_+0], P[B_+1]), a1 = cvtpk(P[B_+2], P[B_+3]);                          \
        unsigned b0_ = cvtpk(P[B_+4], P[B_+5]), b1_ = cvtpk(P[B_+6], P[B_+7]);                                             \
        auto r0 = __builtin_amdgcn_permlane32_swap(a0, b0_, false, false); auto r1 = __builtin_amdgcn_permlane32_swap(a1, b1_, false, false); \
        u32x4 w = {r0[0], r1[0], r0[1], r1[1]}; OUT = __builtin_bit_cast(bf16x8, w); } while (0)
#define EXP4(B_) do { y1[B_] = __builtin_amdgcn_exp2f(y1[B_]); y1[B_+1] = __builtin_amdgcn_exp2f(y1[B_+1]); y1[B_+2] = __builtin_amdgcn_exp2f(y1[B_+2]); y1[B_+3] = __builtin_amdgcn_exp2f(y1[B_+3]); } while (0)
#define SUM8(P, B_) do { ps += ((P[B_] + P[B_+1]) + (P[B_+2] + P[B_+3])) + ((P[B_+4] + P[B_+5]) + (P[B_+6] + P[B_+7])); } while (0)
    QK_LOAD(0, A); QK_LOAD(1, B); SBAR();
    QK_LOAD(2, C);  QK_MMA(0, A);  EXP4(0);  SBAR();
    QK_LOAD(3, A);  QK_MMA(1, B);  EXP4(4);  SBAR();
    QK_LOAD(4, B);  QK_MMA(2, C);  EXP4(8);  SBAR();
    QK_LOAD(5, C);  QK_MMA(3, A);  EXP4(12); SBAR();
    QK_LOAD(6, A);  QK_MMA(4, B);  SUM8(y0, 0); PK4(y0, 0, pa0); SBAR();
    QK_LOAD(7, B);  QK_MMA(5, C);  SUM8(y0, 8); PK4(y0, 8, pa1); SBAR();
    QK_LOAD(8, C);  QK_MMA(6, A);  SUM8(y1, 0); SBAR();
    QK_LOAD(9, A);  QK_MMA(7, B);  SUM8(y1, 8); SBAR();
    QK_LOAD(10, B); QK_MMA(8, C);  { auto rr = __builtin_amdgcn_permlane32_swap(__float_as_uint(ps), __float_as_uint(ps), false, false); ps = __uint_as_float(rr[0]) + __uint_as_float(rr[1]); l_reg = l_reg * alpha + ps; } SBAR();
    QK_LOAD(11, C); QK_MMA(9, A);  PK4(y1, 0, pa2); SBAR();
    QK_MMA(10, B); PK4(y1, 8, pa3); SBAR();
    QK_MMA(11, C); SBAR();
#undef QK_LOAD
#undef QK_MMA
#undef PK4
#undef EXP4
#undef SUM8
}
template <int VB>
__device__ __forceinline__ void pv_tile(f32x16* o, lptr vb0, bf16x8 pa0, bf16x8 pa1, bf16x8 pa2, bf16x8 pa3) {
#define PV_LD(d0, S) do { lptr b_ = vb0 + VB * SHM_V + v_rd_off(d0, 0, 0); \
        S##l0 = vtr(b_); S##h0 = vtr(b_ + 2048); S##l1 = vtr(b_ + 4096); S##h1 = vtr(b_ + 6144); S##l2 = vtr(b_ + 8192); S##h2 = vtr(b_ + 10240); S##l3 = vtr(b_ + 12288); S##h3 = vtr(b_ + 14336); } while (0)
#define PV_MM(d0, S) do { \
        o[d0] = __builtin_amdgcn_mfma_f32_32x32x16_bf16(pa0, (bf16x8){S##l0[0], S##l0[1], S##l0[2], S##l0[3], S##h0[0], S##h0[1], S##h0[2], S##h0[3]}, o[d0], 0, 0, 0);   \
        o[d0] = __builtin_amdgcn_mfma_f32_32x32x16_bf16(pa1, (bf16x8){S##l1[0], S##l1[1], S##l1[2], S##l1[3], S##h1[0], S##h1[1], S##h1[2], S##h1[3]}, o[d0], 0, 0, 0);   \
        o[d0] = __builtin_amdgcn_mfma_f32_32x32x16_bf16(pa2, (bf16x8){S##l2[0], S##l2[1], S##l2[2], S##l2[3], S##h2[0], S##h2[1], S##h2[2], S##h2[3]}, o[d0], 0, 0, 0);   \
        o[d0] = __builtin_amdgcn_mfma_f32_32x32x16_bf16(pa3, (bf16x8){S##l3[0], S##l3[1], S##l3[2], S##l3[3], S##h3[0], S##h3[1], S##h3[2], S##h3[3]}, o[d0], 0, 0, 0); } while (0)
    s16x4 Al0, Ah0, Al1, Ah1, Al2, Ah2, Al3, Ah3, Bl0, Bh0, Bl1, Bh1, Bl2, Bh2, Bl3, Bh3;
    PV_LD(0, A); SBAR();
    PV_LD(1, B); PV_MM(0, A); SBAR();
    PV_LD(2, A); PV_MM(1, B); SBAR();
    PV_LD(3, B); PV_MM(2, A); SBAR();
    PV_MM(3, B);
#undef PV_LD
#undef PV_MM
}
__device__ __forceinline__ unsigned mul_bf16x2(unsigned a, unsigned g) {
    const float al = __uint_as_float(a << 16), ah = __uint_as_float(a & 0xffff0000u), gl = __uint_as_float(g << 16), gh = __uint_as_float(g & 0xffff0000u);
    return cvtpk(al * gl, ah * gh);
}
__device__ __forceinline__ unsigned mul_silu_bf16x2(unsigned a, unsigned g) {
    const float al = __uint_as_float(a << 16), ah = __uint_as_float(a & 0xffff0000u), gl = __uint_as_float(g << 16), gh = __uint_as_float(g & 0xffff0000u);
    return cvtpk(al * pg8::silu_f(gl), ah * pg8::silu_f(gh));
}
#if defined(FUSE34) && !defined(PROBE_Y_PLAIN)
#define Y_AUX 16
#else
#define Y_AUX NT_AUX
#endif
struct Tensors { const bf16_t *Q, *KN, *KR, *VV, *GA; bf16_t* Y; const float* SSQ; const int *pos, *pmin, *pmax, *hmin; };
typedef __amdgpu_buffer_rsrc_t rsrc_t;
__device__ __forceinline__ rsrc_t mkrsrc(const void* p, unsigned bytes) { return __builtin_amdgcn_make_buffer_rsrc((void*)p, 0, bytes, 0x00020000); }
__device__ __forceinline__ bf16x8 bload(rsrc_t r, int voff, int soff) { return __builtin_bit_cast(bf16x8, __builtin_amdgcn_raw_buffer_load_b128(r, voff, soff, 0)); }
__device__ __forceinline__ void mask_tile_pos(f32x16& p0, f32x16& p1, int pq, rsrc_t rP, int pvo, int pso) {
    const float NEG = -__builtin_inff();
#pragma unroll
    for (int g = 0; g < 4; ++g) { const i32x4 a = __builtin_bit_cast(i32x4, __builtin_amdgcn_raw_buffer_load_b128(rP, pvo + 32 * g, pso, 0)), b = __builtin_bit_cast(i32x4, __builtin_amdgcn_raw_buffer_load_b128(rP, pvo + 128 + 32 * g, pso, 0));
#pragma unroll
        for (int i = 0; i < 4; ++i) { if (pq < a[i]) p0[4 * g + i] = NEG; if (pq < b[i]) p1[4 * g + i] = NEG; }
        asm volatile("" ::: "memory"); }
}
__device__ __forceinline__ void mask_tile_lds(f32x16& p0, f32x16& p1, int pq, lptr mp, int hi) {
    const float NEG = -__builtin_inff();
#pragma unroll
    for (int g = 0; g < 4; ++g) { const i32x4 a = *(const ATT_LAS i32x4*)(mp + (8 * g + 4 * hi) * 4), b = *(const ATT_LAS i32x4*)(mp + (32 + 8 * g + 4 * hi) * 4);
#pragma unroll
        for (int i = 0; i < 4; ++i) { if (pq < a[i]) p0[4 * g + i] = NEG; if (pq < b[i]) p1[4 * g + i] = NEG; } }
}
__device__ __forceinline__ void attn_unit(int b, int h, int qb, const Tensors& T, lptr lds) {
    int tid = threadIdx.x; asm volatile("" : "+v"(tid));
    const int wid = __builtin_amdgcn_readfirstlane(tid >> 6), lane = tid & 63, r32 = lane & 31, hi = lane >> 5;
    const int rowbase = b * SEQ, q0 = qb * QB;
    constexpr unsigned MTOK = 65536u;
    const rsrc_t rQ = mkrsrc(T.Q, MTOK * 768u * 2u), rKN = mkrsrc(T.KN, MTOK * 512u * 2u), rKR = mkrsrc(T.KR, MTOK * 64u * 2u), rVV = mkrsrc(T.VV, MTOK * 512u * 2u),
                 rGA = mkrsrc(T.GA, MTOK * 512u * 2u), rY = mkrsrc(T.Y, MTOK * 1024u * 2u), rP = mkrsrc(T.pos, MTOK * 4u);
    lptr V_lds = lds + LDS_V; lptr K_lds = lds + LDS_K; lptr QRw = lds + LDS_QR + wid * SHM_QR;
    ATT_LAS float* ws = (ATT_LAS float*)(lds + LDS_WS) + wid * 64; ATT_LAS float* li_l = ws; ATT_LAS float* al_l = ws + 32;
    const int sr = tid >> 4, sc = tid & 15, rr = tid >> 3, rc = tid & 7;
    const int kw0 = sr * KROW + sc * 16, kw2 = rr * KROW + 256 + rc * 16;
    const int vst0 = v_st(sr, sc * 8); constexpr int vst1d = 8192;
    const int kv_vo = (sr * 512 + sc * 8) * 2, kr_vo = (rr * 64 + rc * 8) * 2;
    const int kv_s0 = (rowbase * 512 + h * 128) * 2, kr_s0 = rowbase * 64 * 2;
    bf16x8 st_k0, st_k1, st_k2, st_v0, st_v1;
#define VMW() asm volatile("s_waitcnt vmcnt(0)" ::: "memory")
#define SLOAD(t) do { const int so_ = kv_s0 + (t) * 65536; st_v0 = bload(rVV, kv_vo, so_); st_v1 = bload(rVV, kv_vo, so_ + 32768); \
        st_k0 = bload(rKN, kv_vo, so_); st_k1 = bload(rKN, kv_vo, so_ + 32768); st_k2 = bload(rKR, kr_vo, kr_s0 + (t) * 8192); } while (0)
#define SWRITE(bf) do { *(ATT_LAS bf16x8*)(V_lds + (bf) * SHM_V + vst0) = st_v0; *(ATT_LAS bf16x8*)(V_lds + (bf) * SHM_V + vst0 + vst1d) = st_v1; \
        *(ATT_LAS bf16x8*)(K_lds + (bf) * SHM_K + kw0) = st_k0; *(ATT_LAS bf16x8*)(K_lds + (bf) * SHM_K + kw0 + 32 * KROW) = st_k1; *(ATT_LAS bf16x8*)(K_lds + (bf) * SHM_K + kw2) = st_k2; } while (0)
    SLOAD(0);
    bf16x8 qr[NQREG], qtmp[8]; int qw_off;
    { const int q_s0 = ((rowbase + q0 + wid * QBLK) * 768 + h * 192) * 2;
      int lp = lane; asm volatile("" : "+v"(lp));
      const int qf_vo = ((lp & 31) * 768 + (lp >> 5) * 8) * 2;
#pragma unroll
      for (int d0 = 0; d0 < NQREG; ++d0) qr[d0] = bload(rQ, qf_vo + d0 * 32, q_s0);
      const int row = lp >> 1, c0 = (lp & 1) * 8; const int qc_vo = (row * 768 + 64 + c0 * 8) * 2;
#pragma unroll
      for (int j = 0; j < 8; ++j) qtmp[j] = bload(rQ, qc_vo + j * 16, q_s0);
      qw_off = row * QRROW + c0 * 16; }
    const int tb = qb * 4 < 28 ? qb * 4 : 28;
    const int pq_u = __builtin_amdgcn_raw_buffer_load_b32(rP, r32 * 4, (rowbase + q0 + wid * QBLK) * 4, 0);
    int mp_v = 0; if (tid < 256) mp_v = __builtin_amdgcn_raw_buffer_load_b32(rP, tid * 4, (rowbase + tb * KVBLK) * 4, 0);
    int NT;
    { const int* pmx = T.pmax + b * 32 + 4 * qb; const int qmax = max(max(pmx[0], pmx[1]), max(pmx[2], pmx[3]));
      const int pml = T.pmin[b * 32 + (lane & 31)];
      const unsigned m32 = (unsigned)__ballot(pml <= qmax);
      NT = m32 ? 32 - __clz(m32) : 1; NT = __builtin_amdgcn_readfirstlane(NT); }
    const int qminw = __builtin_amdgcn_readfirstlane(T.hmin[b * 64 + qb * 8 + wid]);
    const unsigned mbits = (unsigned)__builtin_amdgcn_readfirstlane((int)(unsigned)__ballot(T.pmax[b * 32 + (lane & 31)] > qminw));
    float rq;
    { const f32x4* sp = (const f32x4*)(T.SSQ + (size_t)(rowbase + q0 + wid * QBLK + r32) * 8); const f32x4 s0 = sp[0], s1 = sp[1];
      rq = __builtin_amdgcn_rsqf((((s0[0] + s0[1]) + (s0[2] + s0[3])) + ((s1[0] + s1[1]) + (s1[2] + s1[3]))) * (1.0f / 512.0f) + 1e-6f) * (0.07216878364870323f * 1.4426950408889634f); }
#pragma unroll
    for (int j = 0; j < 8; ++j) *(ATT_LAS bf16x8*)(QRw + qw_off + j * 16) = qtmp[j];
    if (tid < 256) *(ATT_LAS int*)(lds + LDS_MP + tid * 4) = mp_v;
    lptr qrb = QRw + r32 * QRROW + hi * 16;
    lptr kbase = K_lds + r32 * KROW + hi * 16;
    lptr vb0 = V_lds + v_rd_base(lane);
    float m_reg = -1e30f, l_reg = 0.f; f32x16 o[4] = {};
#define RESC(a) do { if (__any((a) < 1.f)) { if (hi == 0) al_l[r32] = (a); asm volatile("s_waitcnt lgkmcnt(0)" ::: "memory");              \
                     _Pragma("unroll") for (int d_ = 0; d_ < 4; ++d_) _Pragma("unroll") for (int r = 0; r < 16; ++r) o[d_][r] *= al_l[crow(r, hi)]; } } while (0)
#ifdef ATT_MPLDS
#define MASKT(P0_, P1_, t) do { if ((mbits >> (t)) & 1u) { if ((t) >= tb && (t) < tb + 4) mask_tile_lds(P0_, P1_, pq_u, lds + LDS_MP + ((t) - tb) * 256, hi); \
        else mask_tile_pos(P0_, P1_, pq_u, rP, hi * 16, (rowbase + (t) * KVBLK) * 4); } } while (0)
#else
#define MASKT(P0_, P1_, t) do { if ((mbits >> (t)) & 1u) mask_tile_pos(P0_, P1_, __builtin_amdgcn_raw_buffer_load_b32(rP, r32 * 4, (rowbase + q0 + wid * QBLK) * 4, 0), rP, hi * 16, (rowbase + (t) * KVBLK) * 4); } while (0)
#endif
    f32x16 pA0, pA1, pB0, pB1; float alA, alB; bf16x8 pa0, pa1, pa2, pa3;
    VMW(); SWRITE(0);
    if (NT > 1) SLOAD(1);
    __syncthreads();
    SBAR(); qkt<0>(pA0, pA1, kbase, qrb, qr);
    MASKT(pA0, pA1, 0); partialSM(pA0, pA1, m_reg, alA, rq);
    if (NT > 1) { VMW(); SWRITE(1); }
    __syncthreads();
#define HALF_STEP(PX0, PX1, alX, PY0, PY1, alY, t, KB, VB, SB) do {                                                      \
        SBAR(); if ((t) + 1 < NT) { SLOAD((t) + 1); SBAR(); }     \
        qkt_fsm<KB>(PX0, PX1, kbase, qrb, qr, PY0, PY1, alY, l_reg, pa0, pa1, pa2, pa3); SBAR();                          \
        pv_tile<VB>(o, vb0, pa0, pa1, pa2, pa3); MASKT(PX0, PX1, (t)); partialSM(PX0, PX1, m_reg, alX, rq);                   \
        __syncthreads();                                                                                                  \
        if ((t) + 1 < NT) { VMW(); SWRITE(SB); }                                                                          \
        RESC(alX); __syncthreads(); } while (0)
    for (int t = 1; t + 1 < NT; t += 2) {
        HALF_STEP(pB0, pB1, alB, pA0, pA1, alA, t, 1, 0, 0);
        HALF_STEP(pA0, pA1, alA, pB0, pB1, alB, t + 1, 0, 1, 1);
    }
    const bool even = (NT & 1) == 0;
    if (even) { SBAR(); qkt<1>(pB0, pB1, kbase, qrb, qr); SBAR(); }
    finishSM(pA0, pA1, alA, l_reg, pa0, pa1, pa2, pa3); SBAR();
    pv_tile<0>(o, vb0, pa0, pa1, pa2, pa3);
    if (even) { MASKT(pB0, pB1, NT - 1); partialSM(pB0, pB1, m_reg, alB, rq); RESC(alB);
        finishSM(pB0, pB1, alB, l_reg, pa0, pa1, pa2, pa3); SBAR(); pv_tile<1>(o, vb0, pa0, pa1, pa2, pa3); }
#ifdef ATT_GPF
    u32x4 gpf[8];
    { int le = lane; asm volatile("" : "+v"(le)); const int g_vo = ((le >> 4) * 512 + (le & 15) * 8) * 2; const int tok0 = rowbase + q0 + wid * QBLK;
#pragma unroll
      for (int i = 0; i < 8; ++i) gpf[i] = __builtin_amdgcn_raw_buffer_load_b128(rGA, g_vo, ((tok0 + i * 4) * 512 + h * 128) * 2, 0); }
#endif
    if (hi == 0) li_l[r32] = l_reg; asm volatile("s_waitcnt lgkmcnt(0)" ::: "memory");
    float rli[16];
#pragma unroll
    for (int r = 0; r < 16; ++r) rli[r] = __builtin_amdgcn_rcpf(li_l[crow(r, hi)]);
    __syncthreads();
    lptr stg = lds + wid * 8192;
#pragma unroll
    for (int r = 0; r < 16; ++r) { const int orow = crow(r, hi);
#pragma unroll
        for (int d0 = 0; d0 < 4; ++d0) *(ATT_LAS unsigned short*)(stg + orow * 256 + (d0 * 32 + r32) * 2) = (unsigned short)(cvtpk(o[d0][r] * rli[r], 0.f) & 0xffffu); }
    asm volatile("s_waitcnt lgkmcnt(0)" ::: "memory");
    { int le = lane; asm volatile("" : "+v"(le)); const int rowl = le >> 4, ch = le & 15; const int g_vo = (rowl * 512 + ch * 8) * 2, y_vo = (rowl * 1024 + ch * 8) * 2;
      const int tok0 = rowbase + q0 + wid * QBLK;
#pragma unroll
      for (int i = 0; i < 8; ++i) {
        const u32x4 ov = *(const ATT_LAS u32x4*)(stg + (i * 4 + rowl) * 256 + ch * 16);
#ifdef ATT_GPF
        const u32x4 gv = gpf[i];
#else
        const u32x4 gv = __builtin_amdgcn_raw_buffer_load_b128(rGA, g_vo, ((tok0 + i * 4) * 512 + h * 128) * 2, 0);
#endif
        u32x4 y;
#if GA_SILU_IN_ATTN
        y.x = mul_silu_bf16x2(ov.x, gv.x); y.y = mul_silu_bf16x2(ov.y, gv.y); y.z = mul_silu_bf16x2(ov.z, gv.z); y.w = mul_silu_bf16x2(ov.w, gv.w);
#else
        y.x = mul_bf16x2(ov.x, gv.x); y.y = mul_bf16x2(ov.y, gv.y); y.z = mul_bf16x2(ov.z, gv.z); y.w = mul_bf16x2(ov.w, gv.w);
#endif
        __builtin_amdgcn_raw_buffer_store_b128(y, rY, y_vo + ((tok0 + i * 4) * 1024 + h * 128) * 2, 0, Y_AUX); } }
#if defined(FUSE34) && !defined(FUSE34_KROT)
    asm volatile("s_waitcnt vmcnt(0)" ::: "memory");
#endif
    __syncthreads();
#undef RESC
#undef MASKT
#undef HALF_STEP
#undef SLOAD
#undef SWRITE
#undef VMW
}
#undef SBAR
}
namespace pool {
#define POOL_LAS __attribute__((address_space(3)))
typedef unsigned short bf16_t;
typedef short bf16x8 __attribute__((ext_vector_type(8)));
typedef float f32x16 __attribute__((ext_vector_type(16)));
typedef unsigned u32x4 __attribute__((ext_vector_type(4)));
typedef unsigned u32x2 __attribute__((ext_vector_type(2)));
typedef POOL_LAS char* lptr;
constexpr int ROWB = 272;
constexpr int LDS_A = 0, LDS_W = 256 * ROWB, LDS_BYTES = LDS_W + 128 * ROWB;
typedef float f32x2_t __attribute__((ext_vector_type(2))); typedef __bf16 bf16x2_t __attribute__((ext_vector_type(2)));
__device__ __forceinline__ unsigned cvtpk(float lo, float hi) { f32x2_t v = {lo, hi}; bf16x2_t b = __builtin_convertvector(v, bf16x2_t); return __builtin_bit_cast(unsigned, b); }
__device__ __forceinline__ void unpack8(const u32x4 v, float (&f)[8]) {
    f[0] = __uint_as_float(v.x << 16); f[1] = __uint_as_float(v.x & 0xffff0000u); f[2] = __uint_as_float(v.y << 16); f[3] = __uint_as_float(v.y & 0xffff0000u);
    f[4] = __uint_as_float(v.z << 16); f[5] = __uint_as_float(v.z & 0xffff0000u); f[6] = __uint_as_float(v.w << 16); f[7] = __uint_as_float(v.w & 0xffff0000u);
}
template <int W, bool EDGE>
__device__ __forceinline__ void pool_rows(const bf16_t* Ug  , int s0, lptr dst  ) {
    u32x4 rv[W + 7];
#pragma unroll
    for (int j = 0; j < W + 7; ++j) { const int jj = j - (W - 1); const bool ok = (s0 + jj) >= 0;
        if constexpr (EDGE) { const u32x4 v = *(const u32x4*)(Ug + (ptrdiff_t)(ok ? jj : 0) * 512); rv[j] = ok ? v : (u32x4){0u, 0u, 0u, 0u}; }
        else rv[j] = *(const u32x4*)(Ug + (ptrdiff_t)jj * 512); }
    float S[8];
#pragma unroll
    for (int c = 0; c < 8; ++c) S[c] = 0.f;
#pragma unroll
    for (int j = 0; j < W - 1; ++j) { float f[8]; unpack8(rv[j], f);
#pragma unroll
        for (int c = 0; c < 8; ++c) S[c] += f[c]; }
#pragma unroll
    for (int i = 0; i < 8; ++i) { float f[8]; unpack8(rv[i + W - 1], f);
#pragma unroll
        for (int c = 0; c < 8; ++c) S[c] += f[c];
        const int cnt = (s0 + i + 1) < W ? (s0 + i + 1) : W; const float ic = 1.0f / (float)cnt;
        u32x4 o; o.x = cvtpk(S[0] * ic - f[0], S[1] * ic - f[1]); o.y = cvtpk(S[2] * ic - f[2], S[3] * ic - f[3]); o.z = cvtpk(S[4] * ic - f[4], S[5] * ic - f[5]); o.w = cvtpk(S[6] * ic - f[6], S[7] * ic - f[7]);
        *(POOL_LAS u32x4*)(dst + i * ROWB) = o;
        float g[8]; unpack8(rv[i], g);
#pragma unroll
        for (int c = 0; c < 8; ++c) S[c] -= g[c]; }
}
struct Tensors { const bf16_t *U, *GB, *PWT; bf16_t* Y; };
__device__ __forceinline__ void pool_unit(int pm, int g, const Tensors& T, lptr lds, int npm = -1, int ng = 0) {
    int tid = threadIdx.x; asm volatile("" : "+v"(tid));
    const int wid = __builtin_amdgcn_readfirstlane(tid >> 6), lane = tid & 63, r32 = lane & 31, hi = lane >> 5;
    __syncthreads();
#ifdef POOL_GPF
    u32x4 gpf[8];
#pragma unroll
    for (int i = 0; i < 8; ++i) { const int row = i * 4 + (lane >> 4), ch = lane & 15; const size_t tok = (size_t)pm * 256 + wid * 32 + row; gpf[i] = *(const u32x4*)(T.GB + tok * 512 + g * 128 + ch * 8); }
#endif
#ifdef POOL_GPF
    u32x4 wpf[4];
    { const bf16_t* w = T.PWT + (size_t)g * 128 * 128;
#pragma unroll
      for (int i = 0; i < 4; ++i) { const int id = tid + 512 * i, n = id >> 4, ch = id & 15; wpf[i] = *(const u32x4*)(w + n * 128 + ch * 8); } }
#else
    { const bf16_t* w = T.PWT + (size_t)g * 128 * 128;
#pragma unroll
      for (int i = 0; i < 4; ++i) { const int id = tid + 512 * i, n = id >> 4, ch = id & 15; *(POOL_LAS u32x4*)(lds + LDS_W + n * ROWB + ch * 16) = *(const u32x4*)(w + n * 128 + ch * 8); } }
#endif
    { const int ch = tid & 15, rg = tid >> 4; const size_t tok = (size_t)pm * 256 + rg * 8; const int s0 = (int)(tok & 2047);
      const bf16_t* Ug = T.U + tok * 512 + g * 128 + ch * 8; lptr dst = lds + LDS_A + rg * 8 * ROWB + ch * 16;
      if ((pm & 7) == 0) { if (g == 0) pool_rows<2, true>(Ug, s0, dst); else if (g == 1) pool_rows<4, true>(Ug, s0, dst); else if (g == 2) pool_rows<8, true>(Ug, s0, dst); else pool_rows<16, true>(Ug, s0, dst); }
      else { if (g == 0) pool_rows<2, false>(Ug, s0, dst); else if (g == 1) pool_rows<4, false>(Ug, s0, dst); else if (g == 2) pool_rows<8, false>(Ug, s0, dst); else pool_rows<16, false>(Ug, s0, dst); } }
#ifdef POOL_GPF
#pragma unroll
    for (int i = 0; i < 4; ++i) { const int id = tid + 512 * i, n = id >> 4, ch = id & 15; *(POOL_LAS u32x4*)(lds + LDS_W + n * ROWB + ch * 16) = wpf[i]; }
#endif
#ifdef POOL_TOUCH
    unsigned tch0 = 0u, tch1 = 0u;
    if (npm >= 0) { const size_t nt_ = (size_t)npm * 256 + (tid >> 1); const int co = ng * 128 + (tid & 1) * 64;
        tch0 = *(const unsigned*)(T.U + nt_ * 512 + co); tch1 = *(const unsigned*)(T.GB + nt_ * 512 + co); }
#endif
    __syncthreads();
    f32x16 acc[4] = {};
    lptr ab = lds + LDS_W + r32 * ROWB + hi * 16, bb = lds + LDS_A + (wid * 32 + r32) * ROWB + hi * 16;
#pragma unroll
    for (int ks = 0; ks < 8; ++ks) { const bf16x8 bq = *(const POOL_LAS bf16x8*)(bb + ks * 32);
#pragma unroll
        for (int nt = 0; nt < 4; ++nt) { const bf16x8 aw = *(const POOL_LAS bf16x8*)(ab + nt * 32 * ROWB + ks * 32);
            acc[nt] = __builtin_amdgcn_mfma_f32_32x32x16_bf16(aw, bq, acc[nt], 0, 0, 0); } }
    lptr stg = lds + LDS_A + wid * 32 * ROWB;
#pragma unroll
    for (int nt = 0; nt < 4; ++nt)
#pragma unroll
        for (int rq = 0; rq < 4; ++rq) { u32x2 w; w.x = cvtpk(acc[nt][4 * rq], acc[nt][4 * rq + 1]); w.y = cvtpk(acc[nt][4 * rq + 2], acc[nt][4 * rq + 3]);
            *(POOL_LAS u32x2*)(stg + r32 * ROWB + (32 * nt + 8 * rq + 4 * hi) * 2) = w; }
    asm volatile("s_waitcnt lgkmcnt(0)" ::: "memory");
#pragma unroll
    for (int i = 0; i < 8; ++i) { const int row = i * 4 + (lane >> 4), ch = lane & 15; const size_t tok = (size_t)pm * 256 + wid * 32 + row;
        const u32x4 ov = *(const POOL_LAS u32x4*)(stg + row * ROWB + ch * 16);
#ifdef POOL_GPF
        const u32x4 gv = gpf[i];
#else
        const u32x4 gv = RDP_NT ? __builtin_nontemporal_load((const u32x4*)(T.GB + tok * 512 + g * 128 + ch * 8)) : *(const u32x4*)(T.GB + tok * 512 + g * 128 + ch * 8);
#endif
        u32x4 y;
#if GB_SILU_IN_POOL
        { float of[8], gf[8]; unpack8(ov, of); unpack8(gv, gf);
#pragma unroll
          for (int c = 0; c < 8; ++c) of[c] *= pg8::silu_f(gf[c]);
          y.x = cvtpk(of[0], of[1]); y.y = cvtpk(of[2], of[3]); y.z = cvtpk(of[4], of[5]); y.w = cvtpk(of[6], of[7]); }
#else
        y.x = attn::mul_bf16x2(ov.x, gv.x); y.y = attn::mul_bf16x2(ov.y, gv.y); y.z = attn::mul_bf16x2(ov.z, gv.z); y.w = attn::mul_bf16x2(ov.w, gv.w);
#endif
#ifdef FUSE34_POOL
        __builtin_amdgcn_raw_buffer_store_b128(y, __builtin_amdgcn_make_buffer_rsrc((void*)T.Y, 0, 65536u * 1024u * 2u, 0x00020000), (int)((tok * 1024 + 512 + g * 128 + ch * 8) * 2), 0, 16); }
#else
        NTST(T.Y + tok * 1024 + 512 + g * 128 + ch * 8, y); }
#endif
#ifdef POOL_TOUCH
    asm volatile("" :: "v"(tch0), "v"(tch1));
#endif
}
}
constexpr int NWAVES = 8;
#ifndef MK_N_LAUNCHES
#define MK_N_LAUNCHES 1
#endif
constexpr int N_LAUNCHES = MK_N_LAUNCHES;
constexpr int PER_PHASE = 5;

constexpr int BATCH = 32, SEQ = 2048, D = 1024, M = BATCH * SEQ;
constexpr int NIN = 2560;
constexpr float LN_EPS = 1e-5f;
constexpr float ALPHA = 1.189207115002721f;

constexpr size_t MiB = 1u << 20;
constexpr size_t WS_CTL = 0, CTL_ZERO_BYTES = 1 * MiB;
constexpr size_t WS_WIN = 2 * MiB, WS_WUQ = 7 * MiB, WS_WUKV = 8 * MiB, WS_PW = 8 * MiB + 512 * 1024, WS_WOUT = 9 * MiB;
constexpr size_t WS_POSMM = 11 * MiB;
constexpr size_t WS_XCH = 12 * MiB, WS_SSQ = 14 * MiB, WS_SSKV = 16 * MiB;
constexpr size_t WS_KR = 24 * MiB, WS_XB = 32 * MiB, WS_Y = 32 * MiB  , WS_XQ = 160 * MiB, WS_XKV = 224 * MiB;
constexpr size_t WS_GA = 256 * MiB, WS_U = 320 * MiB, WS_GB = 384 * MiB, WS_Q = 448 * MiB, WS_KN = 544 * MiB, WS_VV = 608 * MiB, WS_STAT = 672 * MiB  , WS_END = 680 * MiB;
constexpr int CW_TMO = 0, CW_CODE = 1;
constexpr int CW_BAR = 4096;
constexpr int CW_SEAM = 32768;
constexpr int CW_PANEL = 131072;
static_assert((CW_SEAM + 4 * 256 * 64) * 4 <= (int)CTL_ZERO_BYTES, "CTL words inside the memset region");

constexpr int RING_OFF = 0, RING_BYTES = 157696;
constexpr int LDSCTL_OFF = RING_BYTES, MISC_OFF = LDSCTL_OFF + 320;
constexpr int RSTAT_OFF = 131072;
constexpr int LDS_BYTES = 158208;
static_assert(MISC_OFF + 128 <= LDS_BYTES && attn::LDS_BYTES <= RING_BYTES && pool::LDS_BYTES <= RING_BYTES, "LDS map");

struct Frame {
    LAS unsigned char* lds;
    volatile LAS unsigned* MISC;
    gu32* ctl;
    int tid, lane, wave;
    int vcu, G;
};

__device__ __forceinline__ int rope_orig(int p) { return 16 * (p >> 5) + 4 * ((p >> 3) & 3) + (p & 3) + 32 * ((p >> 2) & 1); }
struct Args { const void* in[12]; float* out; unsigned char* ws; int ph_lo, ph_hi, li, pad; };

#ifdef P0_PLAIN_LD
#define P0_LD(p) (*(p))
#else
#define P0_LD(p) __builtin_nontemporal_load(p)
#endif
__device__ __forceinline__ void p0_prologue(const Frame& F, const Args& a) {
    const float* x = (const float*)a.in[0]; const int* pos = (const int*)a.in[1]; const float* w_in = (const float*)a.in[2]; const float* qg = (const float*)a.in[3];
    const float* w_uq = (const float*)a.in[4]; const float* kvg = (const float*)a.in[5]; const float* w_ukv = (const float*)a.in[6]; const float* pool_w = (const float*)a.in[7];
    const float* pool_scale = (const float*)a.in[8]; const float* w_out = (const float*)a.in[9];
    unsigned char* ws = a.ws;
    const size_t gt = (size_t)F.vcu * 512 + F.tid, NTH = (size_t)F.G * 512;
    { const f32x4* x4 = (const f32x4*)x; v4u* xb = (v4u*)(ws + WS_XB);
      for (size_t i = gt; i < (size_t)M * D / 8; i += NTH) { const f32x4 p = P0_LD(x4 + 2 * i), q = P0_LD(x4 + 2 * i + 1); v4u o; o.x = pk2(p[0], p[1]); o.y = pk2(p[2], p[3]); o.z = pk2(q[0], q[1]); o.w = pk2(q[2], q[3]); xb[i] = o; } }
#ifdef LN_POLL
    { v4u* st = (v4u*)(ws + WS_STAT); const v4u z = {0u, 0u, 0u, 0u};
      for (size_t i = gt; i < (size_t)M * 16 * 8 / 16; i += NTH) st[i] = z; }
#endif
    { bf16* wt = (bf16*)(ws + WS_WIN);
      for (size_t idx = gt; idx < (size_t)NIN * 128; idx += NTH) { const int n = (int)(idx % NIN), kc = (int)(idx / NIN);
          int src; if (n < 768) src = n; else if (n < 2304) src = n + 64; else { const int p = n - 2304; src = p < 64 ? 768 + rope_orig(p) : -1; }
          float v[8];
#pragma unroll
          for (int j = 0; j < 8; ++j) v[j] = src >= 0 ? w_in[(size_t)(8 * kc + j) * 2368 + src] : 0.f;
          v4u o; o.x = pk2(v[0], v[1]); o.y = pk2(v[2], v[3]); o.z = pk2(v[4], v[5]); o.w = pk2(v[6], v[7]); *(v4u*)(wt + (size_t)n * 1024 + 8 * kc) = o; } }
    { bf16* wt = (bf16*)(ws + WS_WUQ);
      for (size_t idx = gt; idx < (size_t)768 * 64; idx += NTH) { const int c = (int)(idx % 768), kc = (int)(idx / 768);
          int src; if (c < 512) src = (c >> 7) * 192 + (c & 127); else { const int cc = c - 512; src = (cc >> 6) * 192 + 128 + rope_orig(cc & 63); }
          float v[8];
#pragma unroll
          for (int j = 0; j < 8; ++j) v[j] = qg[8 * kc + j] * w_uq[(size_t)(8 * kc + j) * 768 + src];
          v4u o; o.x = pk2(v[0], v[1]); o.y = pk2(v[2], v[3]); o.z = pk2(v[4], v[5]); o.w = pk2(v[6], v[7]); *(v4u*)(wt + (size_t)c * 512 + 8 * kc) = o; } }
    { bf16* wt = (bf16*)(ws + WS_WUKV);
      for (size_t idx = gt; idx < (size_t)1024 * 32; idx += NTH) { const int c = (int)(idx % 1024), kc = (int)(idx / 1024);
          float v[8];
#pragma unroll
          for (int j = 0; j < 8; ++j) v[j] = kvg[8 * kc + j] * w_ukv[(size_t)(8 * kc + j) * 1024 + c];
          v4u o; o.x = pk2(v[0], v[1]); o.y = pk2(v[2], v[3]); o.z = pk2(v[4], v[5]); o.w = pk2(v[6], v[7]); *(v4u*)(wt + (size_t)c * 256 + 8 * kc) = o; } }
    { bf16* wt = (bf16*)(ws + WS_PW);
      for (size_t idx = gt; idx < (size_t)512 * 16; idx += NTH) { const int gd = (int)(idx % 512), kc = (int)(idx / 512), g = gd >> 7, d = gd & 127; const float sc = pool_scale[gd];
          float v[8];
#pragma unroll
          for (int j = 0; j < 8; ++j) v[j] = sc * pool_w[((size_t)g * 128 + 8 * kc + j) * 128 + d];
          v4u o; o.x = pk2(v[0], v[1]); o.y = pk2(v[2], v[3]); o.z = pk2(v[4], v[5]); o.w = pk2(v[6], v[7]); *(v4u*)(wt + (size_t)gd * 128 + 8 * kc) = o; } }
    { bf16* wt = (bf16*)(ws + WS_WOUT);
      for (size_t idx = gt; idx < (size_t)1024 * 128; idx += NTH) { const int c = (int)(idx % 1024), kc = (int)(idx / 1024);
          float v[8];
#pragma unroll
          for (int j = 0; j < 8; ++j) v[j] = w_out[(size_t)(8 * kc + j) * 1024 + c] * (1.0f / ALPHA);
          v4u o; o.x = pk2(v[0], v[1]); o.y = pk2(v[2], v[3]); o.z = pk2(v[4], v[5]); o.w = pk2(v[6], v[7]); *(v4u*)(wt + (size_t)c * 1024 + 8 * kc) = o; } }
    { int* pmin = (int*)(ws + WS_POSMM); int* pmax = pmin + 1024; int* hmin = pmin + 2048;
      for (int it = F.vcu * NWAVES + F.wave; it < BATCH * 32; it += F.G * NWAVES) { const int v = pos[(size_t)it * 64 + F.lane]; int mn = v, mx = v;
#pragma unroll
          for (int o = 1; o < 32; o <<= 1) { mn = min(mn, __shfl_xor(mn, o)); mx = max(mx, __shfl_xor(mx, o)); }
          const int mno = __shfl_xor(mn, 32), mxo = __shfl_xor(mx, 32);
          if (F.lane == 0) { pmin[it] = min(mn, mno); pmax[it] = max(mx, mxo); hmin[2 * it] = mn; hmin[2 * it + 1] = mno; } } }
}

__global__ void __launch_bounds__(NWAVES * 64, 2) mk_fwd(Args args) {
    extern __shared__ __attribute__((aligned(16))) unsigned char lds[];
    Frame F;
    F.lds = (LAS unsigned char*)lds;
    F.MISC = (volatile LAS unsigned*)(F.lds + MISC_OFF);
    F.tid = threadIdx.x; F.lane = F.tid & 63; F.wave = __builtin_amdgcn_readfirstlane(F.tid >> 6);
    F.G = gridDim.x; { const int bx = blockIdx.x; F.vcu = (F.G % 8 == 0) ? (bx % 8) * (F.G / 8) + bx / 8 : bx; }
#define GRID_BAR(seam) do { if (N_LAUNCHES == PER_PHASE) { if (F.tid == 0) __hip_atomic_store(F.ctl + CW_TMO, 0xBADBA0u | (unsigned)(seam), RLX_AGENT); } \
    else { xcd_barrier(bar); } } while (0)
    unsigned char* ws = args.ws;
    F.ctl = (gu32*)(ws + WS_CTL);
    for (int u = F.tid; u < (LDS_BYTES - LDSCTL_OFF) / 4; u += NWAVES * 64) ((LAS unsigned*)(F.lds + LDSCTL_OFF))[u] = 0u;
    __syncthreads();
    XcdBarrier bar; bar.bar = (unsigned*)(F.ctl + CW_BAR) + args.li * XCD_BAR_WORDS; bar.x = 0; bar.st = nullptr;
    if (N_LAUNCHES != PER_PHASE) bar = xcd_barrier_post((unsigned*)(F.ctl + CW_BAR) + args.li * XCD_BAR_WORDS, F.MISC + 8);
    const int lo = args.ph_lo, hi = args.ph_hi;
#ifndef PH_MASK
#define PH_MASK 31
#endif
#define IN(k) (((PH_MASK >> (k)) & 1) && lo <= (k) && (k) < hi)
#define BOTH(k) (IN(k) && IN((k) + 1))
    typedef pg8::bf16_t b16;
    b16* XB = (b16*)(ws + WS_XB); b16* Y = (b16*)(ws + WS_Y); b16* XQ = (b16*)(ws + WS_XQ); b16* XKV = (b16*)(ws + WS_XKV); b16* KR = (b16*)(ws + WS_KR);
    b16* GA = (b16*)(ws + WS_GA); b16* U = (b16*)(ws + WS_U); b16* GB = (b16*)(ws + WS_GB); b16* Q = (b16*)(ws + WS_Q); b16* KN = (b16*)(ws + WS_KN); b16* VV = (b16*)(ws + WS_VV);
    float* SSQ = (float*)(ws + WS_SSQ);
    const int* pos = (const int*)args.in[1];
    const int* pmin = (const int*)(ws + WS_POSMM); const int* pmax = pmin + 1024; const int* hmin = pmin + 2048;

    if (IN(0)) { p0_prologue(F, args); if (BOTH(0)) GRID_BAR(0); }

    if (IN(1)) {
#ifdef P1_GROUP_STAGGER_US
        { const unsigned long long t0 = __builtin_amdgcn_s_memrealtime(); const unsigned long long w = (unsigned long long)(P1_GROUP_STAGGER_US * 100) * (unsigned)((int)blockIdx.x & 7); while (__builtin_amdgcn_s_memrealtime() - t0 < w) __builtin_amdgcn_s_sleep(8); }
#endif
#ifdef P1_DELAY_US
        if (((int)blockIdx.x >> 3) & 1) { const unsigned long long t0 = __builtin_amdgcn_s_memrealtime(); while (__builtin_amdgcn_s_memrealtime() - t0 < (unsigned long long)(P1_DELAY_US * 100)) __builtin_amdgcn_s_sleep(8); }
#endif
        pg8::Gemm g{XB, (const b16*)(ws + WS_WIN), M, NIN, D}; P1_ORDER S; S.init(M, NIN, F.G, (int)blockIdx.x);
        pg8::EpiP1 E{XQ, XKV, GA, U, GB, KR, SSQ, (LAS float*)(F.lds + RSTAT_OFF), pos};
        pg8::gemm_phase<pg8::EpiP1, P1_ORDER, PG8_ALIGN, PG8_SP2>(F.lds + RING_OFF, g, S, E);
        if (BOTH(1)) GRID_BAR(1);
    }

    if (IN(2)) {
#ifdef P2_DELAY_US
        if (((int)blockIdx.x >> 3) & 1) { const unsigned long long t0 = __builtin_amdgcn_s_memrealtime(); while (__builtin_amdgcn_s_memrealtime() - t0 < (unsigned long long)(P2_DELAY_US * 100)) __builtin_amdgcn_s_sleep(8); }
#endif
#define P2_POOL() do { const pool::Tensors PT{U, GB, (const b16*)(ws + WS_PW), Y}; int i = 0; \
            for (int L = F.vcu; L < (M / 256) * 4; L += F.G, ++i) { const int Ln = L + F.G; \
                pool::pool_unit(P2_PM(L >> 2), ((L & 3) + i) & 3, PT, (pool::lptr)(F.lds + RING_OFF), Ln < (M / 256) * 4 ? P2_PM(Ln >> 2) : -1, ((Ln & 3) + i + 1) & 3); } \
            __syncthreads(); } while (0)
#define P2_GEMM_Q() do { pg8::Gemm g{XQ, (const b16*)(ws + WS_WUQ), M, 768, 512}; P2_ORDER S; S.init(M, 768, F.G, (int)blockIdx.x); pg8::EpiQ E{Q, pos}; \
              pg8::gemm_phase<pg8::EpiQ, P2_ORDER, PG8_ALIGN, PG8_SP2>(F.lds + RING_OFF, g, S, E); } while (0)
#define P2_GEMM_KV() do { pg8::Gemm g{XKV, (const b16*)(ws + WS_WUKV), M, 1024, 256}; P2_ORDER S; S.init(M, 1024, F.G, (int)blockIdx.x); pg8::EpiKV E{KN, VV}; \
              pg8::gemm_phase<pg8::EpiKV, P2_ORDER, PG8_ALIGN, PG8_SP2>(F.lds + RING_OFF, g, S, E); } while (0)
#define P2_GEMMS() do { \
            { pg8::Gemm g{XQ, (const b16*)(ws + WS_WUQ), M, 768, 512}; P2_ORDER S; S.init(M, 768, F.G, (int)blockIdx.x); \
              pg8::EpiQ E{Q, pos}; \
              pg8::gemm_phase<pg8::EpiQ, P2_ORDER, PG8_ALIGN, PG8_SP2>(F.lds + RING_OFF, g, S, E); } \
            { pg8::Gemm g{XKV, (const b16*)(ws + WS_WUKV), M, 1024, 256}; P2_ORDER S; S.init(M, 1024, F.G, (int)blockIdx.x); \
              pg8::EpiKV E{KN, VV}; \
              pg8::gemm_phase<pg8::EpiKV, P2_ORDER, PG8_ALIGN, PG8_SP2>(F.lds + RING_OFF, g, S, E); } } while (0)
#if defined(P2_REP_POOL)
        P2_POOL(); P2_POOL(); P2_GEMMS();
#elif defined(P2_REP_GEMMS)
        P2_GEMMS(); P2_GEMMS(); P2_POOL();
#elif defined(P2_REP_Q)
        P2_GEMM_Q(); P2_GEMMS(); P2_POOL();
#elif defined(P2_REP_KV)
        P2_GEMM_KV(); P2_GEMMS(); P2_POOL();
#elif defined(P2_SWAP_ODD)
        { const int odd = ((int)blockIdx.x >> 3) & 1;
#pragma unroll 1
          for (int t = 0; t < 2; ++t) { if ((t ^ odd) == 0) P2_GEMM_Q(); else P2_GEMM_KV(); } }
        P2_POOL();
#elif defined(P2_KV_FIRST)
        P2_GEMM_KV(); P2_GEMM_Q(); P2_POOL();
#elif defined(P2_KV_LAST)
        P2_GEMM_Q(); P2_POOL(); P2_GEMM_KV();
#elif defined(P2_POOL_FIRST)
        P2_POOL(); P2_GEMMS();
#elif defined(P2_SEQ)
        P2_GEMMS(); P2_POOL();
#elif defined(POOL_IN_P3) || defined(FUSE34_POOL)
        P2_GEMMS();
#else
        P2_GEMMS(); P2_POOL();
#endif
#undef P2_POOL
#undef P2_GEMMS
        if (BOTH(2)) GRID_BAR(2);
    }

#ifdef FUSE34
    if (IN(3)) {
        const attn::Tensors AT{Q, KN, KR, VV, GA, Y, SSQ, pos, pmin, pmax, hmin};
        gu32* pcnt = F.ctl + CW_PANEL + args.li * 256 * 16;
        const int it = F.vcu, bh = it >> 1, bb = bh >> 2, hh = bh & 3;
        const pg8::Gemm g{Y, (const b16*)(ws + WS_WOUT), M, D, D};
        const pg8::EpiOutLnPeer E{(const float*)args.in[0], args.out, (const float*)args.in[10], (const float*)args.in[11], (float*)(ws + WS_STAT), (unsigned*)(F.ctl + CW_SEAM) + args.li * 256 * 64, (unsigned*)(F.ctl + CW_TMO), F.lds + RSTAT_OFF, &bar, (unsigned*)pcnt};
        const int qcyc = (it & 1) ? 0x4532 : 0x1670, vrot = bb & 3;
#ifdef FUSE34_LAG
#pragma unroll 1
        for (int k = 0; k < 5; ++k) {
            if (k < 4) { const int qb = (qcyc >> (4 * ((k + vrot) & 3))) & 15;
                attn::attn_unit(bb, hh, qb, AT, (attn::lptr)(F.lds + RING_OFF));
                if (F.tid == 0) (void)__hip_atomic_fetch_add(pcnt + (8 * bb + qb) * 16, 1u, __ATOMIC_RELAXED, __HIP_MEMORY_SCOPE_AGENT); }
            if (k >= 1) { const int qp = (qcyc >> (4 * ((k - 1 + vrot) & 3))) & 15, pm = 8 * bb + qp;
                if (F.tid == 0) { unsigned sp = 0u;
                    while (__hip_atomic_load(pcnt + pm * 16, __ATOMIC_RELAXED, __HIP_MEMORY_SCOPE_AGENT) < 4u) { __builtin_amdgcn_s_sleep(2);
                        if ((++sp & 1023u) == 0u && (sp > (1u << 22) || __hip_atomic_load(F.ctl + CW_TMO, __ATOMIC_RELAXED, __HIP_MEMORY_SCOPE_AGENT) != 0u)) { __hip_atomic_store(F.ctl + CW_TMO, 1u, __ATOMIC_RELAXED, __HIP_MEMORY_SCOPE_AGENT); break; } } }
                __syncthreads();
                pg8::OneOrder S; S.init(pm, hh);
                pg8::gemm_phase<pg8::EpiOutLnPeer, pg8::OneOrder, true, PG8_SP2>(F.lds + RING_OFF, g, S, E); __syncthreads(); } }
    }
#else
#pragma unroll 1
        for (int k = 0; k < 4; ++k) { int hq = hh, bq = bb; asm volatile("" : "+s"(hq), "+s"(bq));
            const int qb = (qcyc >> (4 * ((k + vrot) & 3))) & 15, pm = 8 * bq + qb;
#ifdef FUSE34_RELOAD
            unsigned char* wq = ws; asm volatile("" : "+s"(wq));
            const attn::Tensors AT{(const b16*)(wq + WS_Q), (const b16*)(wq + WS_KN), (const b16*)(wq + WS_KR), (const b16*)(wq + WS_VV), (const b16*)(wq + WS_GA), (b16*)(wq + WS_Y), (const float*)(wq + WS_SSQ), pos,
                                   (const int*)(wq + WS_POSMM), (const int*)(wq + WS_POSMM) + 1024, (const int*)(wq + WS_POSMM) + 2048};
            const pg8::Gemm g{(const b16*)(wq + WS_Y), (const b16*)(wq + WS_WOUT), M, D, D};
            const pg8::EpiOutLnPeer E{(const float*)args.in[0], args.out, (const float*)args.in[10], (const float*)args.in[11], (float*)(wq + WS_STAT), (unsigned*)(wq + WS_CTL + (size_t)(CW_SEAM + args.li * 256 * 64) * 4), (unsigned*)(wq + WS_CTL + (size_t)CW_TMO * 4), F.lds + RSTAT_OFF, &bar, (unsigned*)(wq + WS_CTL + (size_t)(CW_PANEL + args.li * 256 * 16) * 4)};
#endif
#ifdef FUSE34_POOL
            { unsigned char* wl = ws; asm volatile("" : "+s"(wl));
              const pool::Tensors PT{(const b16*)(wl + WS_U), (const b16*)(wl + WS_GB), (const b16*)(wl + WS_PW), (b16*)(wl + WS_Y)}; pool::pool_unit(pm, hq, PT, (pool::lptr)(F.lds + RING_OFF));
              asm volatile("s_waitcnt vmcnt(0)" ::: "memory"); __syncthreads();
              if (F.tid == 0) (void)__hip_atomic_fetch_add(pcnt + pm * 16 + 1, 1u, __ATOMIC_RELAXED, __HIP_MEMORY_SCOPE_AGENT); }
#endif
#ifdef PROBE_ATTN2
            attn::attn_unit(bq, hq, qb, AT, (attn::lptr)(F.lds + RING_OFF));
#endif
            attn::attn_unit(bq, hq, qb, AT, (attn::lptr)(F.lds + RING_OFF));
#ifdef FUSE34_POOL
            if (F.tid == 0) { unsigned sp = 0u;
                while (__hip_atomic_load(pcnt + pm * 16 + 1, __ATOMIC_RELAXED, __HIP_MEMORY_SCOPE_AGENT) < 4u) { __builtin_amdgcn_s_sleep(2);
                    if ((++sp & 1023u) == 0u && (sp > (1u << 22) || __hip_atomic_load(F.ctl + CW_TMO, __ATOMIC_RELAXED, __HIP_MEMORY_SCOPE_AGENT) != 0u)) { __hip_atomic_store(F.ctl + CW_TMO, 1u, __ATOMIC_RELAXED, __HIP_MEMORY_SCOPE_AGENT); break; } } }
            __syncthreads();
#endif
#ifndef FUSE34_KROT
            if (F.tid == 0) { (void)__hip_atomic_fetch_add(pcnt + pm * 16, 1u, __ATOMIC_RELAXED, __HIP_MEMORY_SCOPE_AGENT); unsigned sp = 0u;
                while (__hip_atomic_load(pcnt + pm * 16, __ATOMIC_RELAXED, __HIP_MEMORY_SCOPE_AGENT) < 4u) { __builtin_amdgcn_s_sleep(2);
                    if ((++sp & 1023u) == 0u && (sp > (1u << 22) || __hip_atomic_load(F.ctl + CW_TMO, __ATOMIC_RELAXED, __HIP_MEMORY_SCOPE_AGENT) != 0u)) { __hip_atomic_store(F.ctl + CW_TMO, 1u, __ATOMIC_RELAXED, __HIP_MEMORY_SCOPE_AGENT); break; } } }
            __syncthreads();
#endif
#ifdef PROBE_P4K2
            _Pragma("unroll 1") for (int rep_ = 1; rep_ >= 0; --rep_) { pg8::OneOrder S; S.init(pm, hq, rep_);
            pg8::gemm_phase<pg8::EpiOutLnPeer, pg8::OneOrder, true, PG8_SP2>(F.lds + RING_OFF, g, S, E); __syncthreads(); } }
#else
            pg8::OneOrder S; S.init(pm, hq);
            pg8::gemm_phase<pg8::EpiOutLnPeer, pg8::OneOrder, true, PG8_SP2>(F.lds + RING_OFF, g, S, E); __syncthreads(); }
#endif
    }
#endif
#else
    if (IN(3)) {
        const attn::Tensors AT{Q, KN, KR, VV, GA, Y, SSQ, pos, pmin, pmax, hmin};
#ifdef POOL_IN_P3
        const pool::Tensors PT{U, GB, (const b16*)(ws + WS_PW), Y};
        { const int it = F.vcu, bh = it >> 1, s = 2 * (it & 1), rot = (it & 1) ? 4 : 0;
#pragma unroll 1
          for (int kk = 0; kk < 8; ++kk) { const int k = (kk + rot) & 7;
              if (k < 4) { const int qb = (k == 0) ? s : (k == 1) ? 7 - s : (k == 2) ? s + 1 : 6 - s; attn::attn_unit(bh >> 2, bh & 3, qb, AT, (attn::lptr)(F.lds + RING_OFF)); }
              else { const int i = k - 4, L = F.vcu + i * F.G; pool::pool_unit(L >> 2, ((L & 3) + i) & 3, PT, (pool::lptr)(F.lds + RING_OFF)); __syncthreads(); } } }
#else
        for (int it = F.vcu; it < BATCH * 4 * 2; it += F.G) { const int bh = it >> 1, s = 2 * (it & 1);
#pragma unroll 1
            for (int k = 0; k < 4; ++k) { const int qb = (k == 0) ? s : (k == 1) ? 7 - s : (k == 2) ? s + 1 : 6 - s;
                attn::attn_unit(bh >> 2, bh & 3, qb, AT, (attn::lptr)(F.lds + RING_OFF)); } }
#endif
        if (BOTH(3)) GRID_BAR(3);
    }

    if (IN(4)) {
#ifdef P4_STAGGER_US
        if (((int)blockIdx.x & 7) >= 4) { const unsigned long long t0 = __builtin_amdgcn_s_memrealtime(); while (__builtin_amdgcn_s_memrealtime() - t0 < (unsigned long long)(P4_STAGGER_US * 100)) __builtin_amdgcn_s_sleep(8); }
#endif
#ifdef PROBE_KLOOP2
        const pg8::Gemm g{Y, (const b16*)(ws + WS_WOUT), M, D, D}; pg8::DupOrder S; S.init(M, D, F.G, (int)blockIdx.x);
#define P4_ORDER pg8::DupOrder
#elif defined(P4_AB)
#ifdef P4_AB_DELAY_US
        if (((int)blockIdx.x >> 3) & 1) { const unsigned long long t0 = __builtin_amdgcn_s_memrealtime(); while (__builtin_amdgcn_s_memrealtime() - t0 < (unsigned long long)(P4_AB_DELAY_US * 100)) __builtin_amdgcn_s_sleep(8); }
#endif
        const pg8::Gemm g{Y, (const b16*)(ws + WS_WOUT), M, D, D}; pg8::AbOrder S; S.init(M, D, F.G, (int)blockIdx.x);
#define P4_ORDER pg8::AbOrder
#else
        const pg8::Gemm g{Y, (const b16*)(ws + WS_WOUT), M, D, D}; pg8::StaticOrder S; S.init(M, D, F.G, (int)blockIdx.x);
#define P4_ORDER pg8::StaticOrder
#endif
        const pg8::EpiOutLnPeer E{(const float*)args.in[0], args.out, (const float*)args.in[10], (const float*)args.in[11], (float*)(ws + WS_STAT), (unsigned*)(F.ctl + CW_SEAM) + args.li * 256 * 64, (unsigned*)(F.ctl + CW_TMO), F.lds + RSTAT_OFF, &bar};
        pg8::gemm_phase<pg8::EpiOutLnPeer, P4_ORDER, true, PG8_SP2>(F.lds + RING_OFF, g, S, E);
    }
#endif
#undef IN
#undef BOTH
}


#ifdef DBG_SEL
__device__ __forceinline__ float dbg_b2f(const unsigned short* p, size_t i) { return __uint_as_float(((unsigned)p[i]) << 16); }
__global__ void dbg_dump(unsigned char* ws, float* out, int sel) {
    const size_t n = (size_t)M * D;
    for (size_t i = blockIdx.x * (size_t)blockDim.x + threadIdx.x; i < n; i += (size_t)gridDim.x * blockDim.x) {
        float v = 0.f;
        if (sel == 1) { v = dbg_b2f((const unsigned short*)(ws + WS_XQ), i % ((size_t)M * 512)) + dbg_b2f((const unsigned short*)(ws + WS_XKV), i % ((size_t)M * 256)) + dbg_b2f((const unsigned short*)(ws + WS_GA), i % ((size_t)M * 512))
                        + dbg_b2f((const unsigned short*)(ws + WS_U), i % ((size_t)M * 512)) + dbg_b2f((const unsigned short*)(ws + WS_GB), i % ((size_t)M * 512)) + dbg_b2f((const unsigned short*)(ws + WS_KR), i % ((size_t)M * 64))
                        + ((const float*)(ws + WS_SSQ))[i % ((size_t)M * 8)] + ((const float*)(ws + WS_SSKV))[i % ((size_t)M * 4)]; }
        else if (sel == 2) { v = dbg_b2f((const unsigned short*)(ws + WS_Q), i % ((size_t)M * 768)) + dbg_b2f((const unsigned short*)(ws + WS_KN), i % ((size_t)M * 512)) + dbg_b2f((const unsigned short*)(ws + WS_VV), i % ((size_t)M * 512)); }
        else if (sel == 3) { const size_t r = i / 1024, c = i % 1024; v = c >= 512 ? dbg_b2f((const unsigned short*)(ws + WS_Y), r * 1024 + c) : 0.f; }
        else if (sel == 4) { const size_t r = i / 1024, c = i % 1024; v = c < 512 ? dbg_b2f((const unsigned short*)(ws + WS_Y), r * 1024 + c) : 0.f; }
        else if (sel == 5) { v = dbg_b2f((const unsigned short*)(ws + WS_WIN), i % ((size_t)NIN * 1024)) + dbg_b2f((const unsigned short*)(ws + WS_WUQ), i % ((size_t)768 * 512)) + dbg_b2f((const unsigned short*)(ws + WS_WUKV), i % ((size_t)1024 * 256))
                        + dbg_b2f((const unsigned short*)(ws + WS_PW), i % ((size_t)512 * 128)) + dbg_b2f((const unsigned short*)(ws + WS_WOUT), i % ((size_t)1024 * 1024)) + dbg_b2f((const unsigned short*)(ws + WS_XB), i) + (float)((const int*)(ws + WS_POSMM))[i % 4096]; }
        out[i] = v;
    }
}
#endif
extern "C" void kernel_launch(void* const* d_in, const int* in_sizes, int n_in, void* d_out, int out_size, void* d_ws, size_t ws_size, hipStream_t stream) {
    static int grid = 0;
    if (grid == 0) {
        if (n_in != 12 || in_sizes[0] != M * D || out_size != M * D || ws_size < WS_END) { fprintf(stderr, "kernel_launch: shape/workspace mismatch (n_in %d in0 %d out %d ws %zu, need ws >= %zu)\n", n_in, n_in > 0 ? in_sizes[0] : -1, out_size, ws_size, (size_t)WS_END); grid = -1; return; }
        int dev = 0, cus = 0, per_cu = 0;
        if (hipGetDevice(&dev) != hipSuccess || hipDeviceGetAttribute(&cus, hipDeviceAttributeMultiprocessorCount, dev) != hipSuccess) { fprintf(stderr, "kernel_launch: device query failed\n"); grid = -1; return; }
        if (hipFuncSetAttribute((const void*)mk_fwd, hipFuncAttributeMaxDynamicSharedMemorySize, LDS_BYTES) != hipSuccess) { fprintf(stderr, "kernel_launch: hipFuncSetAttribute failed\n"); grid = -1; return; }
        if (hipOccupancyMaxActiveBlocksPerMultiprocessor(&per_cu, (const void*)mk_fwd, NWAVES * 64, LDS_BYTES) != hipSuccess || per_cu < 1) fprintf(stderr, "kernel_launch: note: occupancy query reports %d workgroups per CU\n", per_cu);
        (void)hipGetLastError();
        grid = cus;
        if (grid != 256) fprintf(stderr, "kernel_launch: %d CUs; the fused LayerNorm phase needs 256\n", grid);
    }
    if (grid < 0) return;
    if (hipMemsetAsync((char*)d_ws + WS_CTL, 0, CTL_ZERO_BYTES, stream) != hipSuccess) { fprintf(stderr, "kernel_launch: hipMemsetAsync failed\n"); return; }
    Args a{};
    for (int i = 0; i < 12; ++i) a.in[i] = d_in[i];
    a.out = (float*)d_out; a.ws = (unsigned char*)d_ws;
#ifdef DBG_SEL
    for (int li = 0; li <= DBG_UPTO; ++li) { a.ph_lo = li; a.ph_hi = li + 1; a.li = li; hipLaunchKernelGGL(mk_fwd, dim3(grid), dim3(NWAVES * 64), LDS_BYTES, stream, a); }
    hipLaunchKernelGGL(dbg_dump, dim3(2048), dim3(256), 0, stream, (unsigned char*)d_ws, (float*)d_out, DBG_SEL);
    return;
#endif
#ifdef PROBE_PHASE
    a.ph_lo = 0; a.ph_hi = PROBE_PHASE + 1; a.li = 0; hipLaunchKernelGGL(mk_fwd, dim3(grid), dim3(NWAVES * 64), LDS_BYTES, stream, a);
    a.ph_lo = PROBE_PHASE; a.ph_hi = PER_PHASE; a.li = 1; hipLaunchKernelGGL(mk_fwd, dim3(grid), dim3(NWAVES * 64), LDS_BYTES, stream, a);
    return;
#endif
    for (int li = 0; li < N_LAUNCHES; ++li) {
        a.ph_lo = (N_LAUNCHES == PER_PHASE) ? li : 0; a.ph_hi = (N_LAUNCHES == PER_PHASE) ? li + 1 : PER_PHASE; a.li = li;
        hipLaunchKernelGGL(mk_fwd, dim3(grid), dim3(NWAVES * 64), LDS_BYTES, stream, a);
        const hipError_t le = hipPeekAtLastError();
        if (le != hipSuccess) { fprintf(stderr, "kernel_launch: launch %d failed: %s\n", li, hipGetErrorName(le)); break; }
    }
}
```

```cpp
#define FUSE34 1
#define GROUP_BAR 1
#define LN_L2SCOPE 1
#define LN_ROWSTORE 1
#define Y_L2SCOPE 1
#define ATT_PRESTATS 1
#define TILE_GATES 1
#define TILE_Y 1
#define TILE_XQKV 1
#define ROWSUM_PERMLANE 1
#define FUSE34_KROT 1
#define POOL_GPF 1
#define ATT_GPF 1
#define ATT_MPLDS 1
#define ONE_TRIM 1
#define LN_SLOTS_WIDE

#define TILE_U 1
#define TILE_Q 1
#define TILE_KV 1
#define TILE_XB

#define XRES_ROWS 1
#define NT_EPI 1
#define OUT_AUX 0


#define ROPE_P0        1
#include <hip/hip_runtime.h>
#include <cstdio>
#include <cstdint>
#define GAS __attribute__((address_space(1)))
#define LAS __attribute__((address_space(3)))
typedef unsigned short bf16;
typedef unsigned v4u __attribute__((ext_vector_type(4)));
typedef float f32x4 __attribute__((ext_vector_type(4)));
typedef short bf16x8 __attribute__((ext_vector_type(8)));
typedef GAS unsigned gu32;
typedef GAS unsigned long long gu64;
#define RLX_AGENT __ATOMIC_RELAXED, __HIP_MEMORY_SCOPE_AGENT
#define LDS_WAIT() asm volatile("s_waitcnt lgkmcnt(0)" ::: "memory")
#define VM_WAIT() asm volatile("s_waitcnt vmcnt(0)" ::: "memory")
__device__ __forceinline__ unsigned long long rt() { return __builtin_amdgcn_s_memrealtime(); }
__device__ __forceinline__ unsigned f2bf(float f) { unsigned u = __builtin_bit_cast(unsigned, f); return (u + 0x7fffu + ((u >> 16) & 1u)) >> 16; }
__device__ __forceinline__ unsigned pk2(float lo, float hi) { return f2bf(lo) | (f2bf(hi) << 16); }

#define XB_TMO      128
#define XB_XCNT(j)  (256  + 64 * (j))
#define XB_XSUB(j)  (1280 + 64 * (j))
#define XB_XGEN(j)  (2304 + 64 * (j))
#define XB_TOP      3328
#define XB_TOPGEN   3392
#define XCD_BAR_WORDS 3456
#define XB_SPIN_CAP (1u << 18)

__device__ __forceinline__ unsigned xb_ld(unsigned* p)              { return __hip_atomic_load(p, __ATOMIC_RELAXED, __HIP_MEMORY_SCOPE_AGENT); }
__device__ __forceinline__ unsigned xb_add(unsigned* p, unsigned v) { return __hip_atomic_fetch_add(p, v, __ATOMIC_RELAXED, __HIP_MEMORY_SCOPE_AGENT); }
__device__ __forceinline__ unsigned xb_xcc_id() { return (unsigned)__builtin_amdgcn_s_getreg((3 << 11) | 20) & 0xFu; }
#define XB_SPIN(cond, bar) do { unsigned _sp = 0; while (cond) { __builtin_amdgcn_s_sleep(1); \
    if ((++_sp & 255u) == 0u) { if (xb_ld(&(bar)[XB_TMO])) break; if (_sp > XB_SPIN_CAP) { atomicAdd(&(bar)[XB_TMO], 1u); break; } } } } while (0)

struct XcdBarrier {
    unsigned* bar; unsigned x;
    volatile LAS unsigned* st;
};

__device__ __forceinline__ XcdBarrier xcd_barrier_post(unsigned* bar, volatile LAS unsigned* st) {
    XcdBarrier b; b.bar = bar; b.x = xb_xcc_id(); b.st = st;
    if (threadIdx.x == 0) (void)xb_add(&bar[XB_XCNT(b.x)], 1u);
    return b;
}
__device__ __forceinline__ void xcd_barrier_complete(unsigned* bar, unsigned x, unsigned& nloc, unsigned& nx) {
    const unsigned G = gridDim.x * gridDim.y * gridDim.z;
    unsigned sum, cnt, mine, sp = 0u;
    for (;;) {
        sum = 0u; cnt = 0u; mine = 0u;
#pragma unroll
        for (unsigned j = 0; j < 16; ++j) { const unsigned c = xb_ld(&bar[XB_XCNT(j)]); sum += c; cnt += (c > 0u) ? 1u : 0u; mine = (j == x) ? c : mine; }
        if (sum == G) break;
        __builtin_amdgcn_s_sleep(1);
        if ((++sp & 255u) == 0u) { if (xb_ld(&bar[XB_TMO])) break; if (sp > XB_SPIN_CAP) { atomicAdd(&bar[XB_TMO], 1u); break; } }
    }
    nloc = mine > 0u ? mine : 1u; nx = cnt > 0u ? cnt : 1u;
}

__device__ __forceinline__ void xcd_barrier(const XcdBarrier& b) {
    asm volatile("s_waitcnt vmcnt(0)" ::: "memory");
    __syncthreads();
    if (threadIdx.x == 0) {
        unsigned* bar = b.bar;
        __builtin_amdgcn_s_waitcnt(0);
        unsigned nloc = b.st[0], nx = b.st[1];
        if (nloc == 0u) { xcd_barrier_complete(bar, b.x, nloc, nx); b.st[0] = nloc; b.st[1] = nx; }
#ifdef BAR_EARLY_WB
        __builtin_amdgcn_fence(__ATOMIC_RELEASE, "agent");
#endif
        const unsigned old = xb_add(&bar[XB_XSUB(b.x)], 1u);
        const unsigned gen = old / nloc;
        if (old + 1u == (gen + 1u) * nloc) {
            __builtin_amdgcn_fence(__ATOMIC_RELEASE, "agent");
            asm volatile("s_waitcnt vmcnt(0)" ::: "memory");
            const unsigned og = xb_add(&bar[XB_TOP], 1u);
            const unsigned tg = og / nx;
            if (og + 1u == (tg + 1u) * nx) xb_add(&bar[XB_TOPGEN], 1u);
            else XB_SPIN(xb_ld(&bar[XB_TOPGEN]) == tg, bar);
            __builtin_amdgcn_fence(__ATOMIC_ACQUIRE, "agent");
            xb_add(&bar[XB_XGEN(b.x)], 1u);
            asm volatile("s_waitcnt vmcnt(0)" ::: "memory");
        } else {
            XB_SPIN(xb_ld(&bar[XB_XGEN(b.x)]) == gen, bar);
            __builtin_amdgcn_fence(__ATOMIC_ACQUIRE, "agent");
            asm volatile("s_waitcnt vmcnt(0)" ::: "memory");
        }
    }
    __syncthreads();
}

__device__ __forceinline__ void xcd_local_barrier(const XcdBarrier& b, unsigned* lb) {
    asm volatile("s_waitcnt vmcnt(0)" ::: "memory");
    __syncthreads();
    if (threadIdx.x == 0) {
        __builtin_amdgcn_s_waitcnt(0);
        const unsigned nloc = b.st[0];
        const unsigned old = xb_add(&lb[64 * b.x], 1u);
        const unsigned gen = old / nloc;
        if (old + 1u == (gen + 1u) * nloc) xb_add(&lb[1024 + 64 * b.x], 1u);
        else XB_SPIN(xb_ld(&lb[1024 + 64 * b.x]) == gen, b.bar);
        __builtin_amdgcn_fence(__ATOMIC_ACQUIRE, "agent");
        asm volatile("s_waitcnt vmcnt(0)" ::: "memory");
    }
    __syncthreads();
}
#include <hip/hip_runtime.h>
#include <cstdio>
#include <cstdint>
namespace pg8 {
#define PG8_LAS __attribute__((address_space(3)))
typedef unsigned short bf16_t;
typedef short bf16x8 __attribute__((ext_vector_type(8)));
typedef float f32x4 __attribute__((ext_vector_type(4)));
typedef unsigned u32x4 __attribute__((ext_vector_type(4)));
constexpr int BM = 256, BK = 64, HALF = 128, HTB = HALF * BK * 2  , STAGE_BYTES = 8 * HTB, NXCD = 8, WGM = 8;

__host__ __device__ __forceinline__ int lds_byte(int r, int c) { const int st = (r >> 4) * 2 + (c >> 5), rr = r & 15, cc = c & 31, ob = rr * 64 + cc * 2; return st * 1024 + (ob ^ (((ob >> 9) & 1) << 5)); }
__host__ __device__ __forceinline__ void stage_rc(int b, int& R, int& C) { const int st = b / 1024, sb = b % 1024, swz = sb ^ (((sb >> 9) & 1) << 5); R = (st >> 1) * 16 + swz / 64; C = (st & 1) * 32 + (swz % 64) / 2; }
__host__ __device__ __forceinline__ int perm32(int rho) { const int n = rho >> 4, i = rho & 15; return 8 * (i >> 2) + 4 * n + (i & 3); }

struct Unit { int pm, pn, dummy; };
struct Gemm { const bf16_t* A; const bf16_t* Bt; int M, N, K; int tiledA; };

struct StaticOrder {
    static constexpr bool SINGLE = false;
    int nM, nN, nwg, G, c;
    __host__ __device__ void init(int M, int N, int G_, int c_) { nM = M / BM; nN = N / BM; nwg = nM * nN; G = G_; c = c_; }
    __host__ __device__ bool next(int i, Unit& u) const {
        const long L = (long)i * G + c; if (L >= nwg) return false;
        int wgid = (int)L; { const int q = nwg / NXCD, r = nwg % NXCD, xcd = wgid % NXCD, off = wgid / NXCD; wgid = (xcd < r ? xcd * (q + 1) : r * (q + 1) + (xcd - r) * q) + off; }
        const int nig = WGM * nN, gid = wgid / nig, fm = gid * WGM, gsz = (nM - fm) < WGM ? (nM - fm) : WGM;
        u.pm = fm + ((wgid % nig) % gsz); u.pn = (wgid % nig) / gsz; u.dummy = 0; return true;
    }
    __device__ __forceinline__ void a_ready(const Unit&) const {}
    __device__ __forceinline__ void done(const Unit&) const {}
};

__device__ __forceinline__ unsigned cvt_pk_bf16(float lo, float hi) { unsigned r; asm volatile("v_cvt_pk_bf16_f32 %0, %1, %2" : "=v"(r) : "v"(lo), "v"(hi)); return r; }
__device__ __forceinline__ size_t t512(size_t row, int col) { return (row >> 4) * 16384 + (size_t)(col >> 5) * 1024 + (row & 15) * 64 + (size_t)(col & 31) * 2; }
__device__ __forceinline__ float rowsum4(float v) {
#ifdef ROWSUM_PERMLANE
    { auto a = __builtin_amdgcn_permlane16_swap(__float_as_uint(v), __float_as_uint(v), false, false); v = __uint_as_float(a[0]) + __uint_as_float(a[1]); }
    { auto b = __builtin_amdgcn_permlane32_swap(__float_as_uint(v), __float_as_uint(v), false, false); v = __uint_as_float(b[0]) + __uint_as_float(b[1]); }
    return v;
#else
    v += __shfl_xor(v, 16); v += __shfl_xor(v, 32); return v;
#endif
}
#ifdef RD_NT
#define RDX_AUX ((RD_NT) & 1 ? 2 : 0)
#define RDQ_AUX ((RD_NT) & 2 ? 2 : 0)
#define RDP_NT (((RD_NT) & 4) != 0)
#else
#define RDX_AUX 0
#define RDQ_AUX 0
#define RDP_NT 0
#endif
#ifndef GB_SILU_IN_POOL
#define GB_SILU_IN_POOL 1
#endif
#ifndef TILE_XQKV
#define TILE_XQKV 0
#endif
#ifndef TILE_GATES
#define TILE_GATES 0
#endif
#ifndef GA_SILU_IN_ATTN
#define GA_SILU_IN_ATTN 0
#endif
#define PLST(addr, val) (*(u32x4*)(addr) = (val))
#ifdef NT_EPI
#define NTST(addr, val) __builtin_nontemporal_store((val), (u32x4*)(addr))
#define NT_AUX 2
#else
#define NTST(addr, val) (*(u32x4*)(addr) = (val))
#define NT_AUX 0
#endif
__device__ __forceinline__ float silu_f(float x) { return x * __builtin_amdgcn_rcpf(1.0f + __builtin_amdgcn_exp2f(-1.4426950408889634f * x)); }
__device__ __forceinline__ void sincos_rad(float ang, float& s, float& c) {
    const float I2PI_HI = 0.15915494f, I2PI_LO = 6.4206383e-9f;
    const float k = __builtin_rintf(ang * I2PI_HI);
    float r = __builtin_fmaf(ang, I2PI_HI, -k);
    r = __builtin_fmaf(ang, I2PI_LO, r);
    s = __builtin_amdgcn_sinf(r); c = __builtin_amdgcn_cosf(r);
}
__device__ __forceinline__ float rope_inv_freq(int j) { return exp2f(-(float)j * 0.41524101186092029f); }
typedef float f32x2_t __attribute__((ext_vector_type(2))); typedef __bf16 bf16x2_t __attribute__((ext_vector_type(2)));
__device__ __forceinline__ unsigned cvtpk_c(float lo, float hi) { f32x2_t v = {lo, hi}; bf16x2_t b = __builtin_convertvector(v, bf16x2_t); return __builtin_bit_cast(unsigned, b); }
__device__ __forceinline__ u32x4 pack8f(const f32x4 a, const f32x4 b) { u32x4 w; w.x = cvtpk_c(a[0], a[1]); w.y = cvtpk_c(a[2], a[3]); w.z = cvtpk_c(b[0], b[1]); w.w = cvtpk_c(b[2], b[3]); return w; }

struct EpiP1 {
#if defined(ROPE_P0) && !defined(PROBE_ROPE_BOTH)
    static constexpr bool PERM = true, AFTER_DRAIN = false, INIT_ACC = false, XRES = false, HAS_NARROW = false, KHOOK = false; static constexpr int KROT = 0;
    __device__ __forceinline__ bool narrow(const Unit&) const { return false; }
#else
    static constexpr bool PERM = true, AFTER_DRAIN = false, INIT_ACC = false, XRES = false, HAS_NARROW = true, KHOOK = false; static constexpr int KROT = 0;
    __device__ __forceinline__ bool narrow(const Unit& u) const { return u.pn == 9; }
#endif
    __device__ __forceinline__ int nst(const Unit& u) const { return u.pn == 9 ? 0 : 16; }
    bf16_t *XQ, *XKV, *GA, *U, *GB, *KR; float* SSQ; PG8_LAS float* red; const int* pos;
    template <bool ACT, bool SQ, bool TILED, bool STNT = true>
    __device__ __forceinline__ void body(const f32x4 (&acc)[2][2][4][2], bf16_t* dst, int colt, float* ss, int part, int row0, int wc, int fq) const {
        const int col0 = colt + wc * 32 + 8 * fq;
#pragma unroll
        for (int ai = 0; ai < 2; ++ai)
#pragma unroll
            for (int m = 0; m < 4; ++m) { const int row = row0 + ai * HALF + m * 16; bf16_t* rowp = dst + (size_t)row * 512 + col0; float sq = 0.f;
#pragma unroll
                for (int bj = 0; bj < 2; ++bj) { f32x4 v0 = acc[ai][bj][m][0], v1 = acc[ai][bj][m][1];
                    if constexpr (ACT) {
#pragma unroll
                        for (int i = 0; i < 4; ++i) { v0[i] = silu_f(v0[i]); v1[i] = silu_f(v1[i]); } }
                    if constexpr (SQ) sq += (v0[0] * v0[0] + v0[1] * v0[1]) + (v0[2] * v0[2] + v0[3] * v0[3]) + (v1[0] * v1[0] + v1[1] * v1[1]) + (v1[2] * v1[2] + v1[3] * v1[3]);
                    if constexpr (TILED) { if constexpr (STNT) NTST((char*)dst + t512((size_t)row, col0 + bj * HALF), pack8f(v0, v1)); else PLST((char*)dst + t512((size_t)row, col0 + bj * HALF), pack8f(v0, v1)); } else NTST(rowp + bj * HALF, pack8f(v0, v1));
#ifdef PROBE_P1ST_A
                    NTST((char*)(rowp + bj * HALF) + (540u << 20), pack8f(v0, v1));
#endif
#ifdef PROBE_P1ST_B
                    { int tl_ = threadIdx.x; asm volatile("" : "+v"(tl_)); NTST((char*)dst + (540u << 20) + ((size_t)(row0 >> 4) * 16 + (size_t)((ai * 4 + m) * 2 + bj)) * 1024 + (size_t)(tl_ & 63) * 16 + (size_t)colt * 64, pack8f(v0, v1)); }
#endif
                    }
                if constexpr (SQ) { sq = rowsum4(sq); if (fq == 0) ss[(size_t)row * 8 + part] = sq; } }
    }
    __device__ __forceinline__ void operator()(const f32x4 (&acc)[2][2][4][2], const Unit& u, int wr, int wc, int fr, int fq) const {
#ifdef PROBE_P1K2
        if (u.dummy) return;
#endif
        const int row0 = u.pm * BM + wr * 64 + fr; const int pn = u.pn;
#if !defined(ROPE_P0) || defined(PROBE_ROPE_BOTH)
        if (pn == 9) {
            if (wc < 2) {
                float fqv[4];
#pragma unroll
                for (int i = 0; i < 4; ++i) fqv[i] = rope_inv_freq(16 * wc + 4 * fq + i);
                int pv[2][4];
#pragma unroll
                for (int ai = 0; ai < 2; ++ai)
#pragma unroll
                    for (int m = 0; m < 4; ++m) pv[ai][m] = pos[row0 + ai * HALF + m * 16];
#pragma unroll
                for (int ai = 0; ai < 2; ++ai)
#pragma unroll
                    for (int m = 0; m < 4; ++m) { const int row = row0 + ai * HALF + m * 16; const float pf = (float)pv[ai][m];
                        const f32x4 t1 = acc[ai][0][m][0], t2 = acc[ai][0][m][1]; f32x4 o1, o2;
#pragma unroll
                        for (int i = 0; i < 4; ++i) { float s, c; sincos_rad(pf * fqv[i], s, c); o1[i] = t1[i] * c - t2[i] * s; o2[i] = t1[i] * s + t2[i] * c; }
                        NTST(KR + (size_t)row * 64 + 32 * wc + 8 * fq, pack8f(o1, o2)); }
            }
            return;
        }
#endif
        if (pn == 2) {
            float sqv[2][4];
#pragma unroll
            for (int ai = 0; ai < 2; ++ai)
#pragma unroll
                for (int m = 0; m < 4; ++m) { float sq = 0.f;
#pragma unroll
                    for (int bj = 0; bj < 2; ++bj)
#pragma unroll
                        for (int n = 0; n < 2; ++n) { const f32x4 v = acc[ai][bj][m][n]; sq += (v[0] * v[0] + v[1] * v[1]) + (v[2] * v[2] + v[3] * v[3]); }
                    sq = rowsum4(sq); sqv[ai][m] = sq;
                    if (fq == 0) red[(ai * HALF + wr * 64 + m * 16 + fr) * 4 + wc] = sq; }
            asm volatile("s_waitcnt lgkmcnt(0)" ::: "memory"); __builtin_amdgcn_s_barrier(); asm volatile("" ::: "memory");
#pragma unroll
            for (int ai = 0; ai < 2; ++ai)
#pragma unroll
                for (int m = 0; m < 4; ++m) { const int row = row0 + ai * HALF + m * 16; const PG8_LAS f32x4* rp = (const PG8_LAS f32x4*)(red + (ai * HALF + wr * 64 + m * 16 + fr) * 4); const f32x4 t = *rp;
                    const float rinv = __builtin_amdgcn_rsqf(((t[0] + t[1]) + (t[2] + t[3])) * (1.0f / 256.0f) + 1e-6f);
                    bf16_t* rowp = XKV + (size_t)row * 256 + wc * 32 + 8 * fq;
#pragma unroll
                    for (int bj = 0; bj < 2; ++bj) {
#if TILE_XQKV
                        PLST((char*)XKV + ((size_t)(row >> 4) * 8 + (size_t)(bj * 4 + wc)) * 1024 + (row & 15) * 64 + fq * 16, pack8f(acc[ai][bj][m][0] * rinv, acc[ai][bj][m][1] * rinv));
#else
                        NTST(rowp + bj * HALF, pack8f(acc[ai][bj][m][0] * rinv, acc[ai][bj][m][1] * rinv));
#endif
                    } }
            asm volatile("s_waitcnt lgkmcnt(0)" ::: "memory"); __builtin_amdgcn_s_barrier(); asm volatile("" ::: "memory");
            return;
        }
        if (pn < 2) body<false, true, TILE_XQKV, false>(acc, XQ, pn * 256, SSQ, pn * 4 + wc, row0, wc, fq);
        else if (pn < 5) body<!GA_SILU_IN_ATTN, false, TILE_GATES>(acc, GA, (pn - 3) * 256, nullptr, 0, row0, wc, fq);
        else if (pn < 7) body<false, false, TILE_U>(acc, U, (pn - 5) * 256, nullptr, 0, row0, wc, fq);
        else body<!GB_SILU_IN_POOL, false, TILE_GATES>(acc, GB, (pn - 7) * 256, nullptr, 0, row0, wc, fq);
    }
};

constexpr float QSCALE = 0.07216878364870323f * 1.4426950408889634f;
#define QT_OFF(row, head, cb) (((((size_t)((row) >> 11) * 4 + (head)) * 128 + (((row) & 2047) >> 4)) * 6 + (cb)) * 1024 + ((row) & 15) * 64)
struct EpiQ {
    static constexpr bool PERM = true, AFTER_DRAIN = false, INIT_ACC = false, XRES = false, HAS_NARROW = false, KHOOK = false; static constexpr int KROT = 0;
    __device__ __forceinline__ bool narrow(const Unit&) const { return false; }
    __device__ __forceinline__ int nst(const Unit&) const { return 16; }
    bf16_t* Q; const int* pos;
    __device__ __forceinline__ void operator()(const f32x4 (&acc)[2][2][4][2], const Unit& u, int wr, int wc, int fr, int fq) const {
        const int row0 = u.pm * BM + wr * 64 + fr; const int pn = u.pn;
        if (pn < 2) {
#pragma unroll
            for (int ai = 0; ai < 2; ++ai)
#pragma unroll
                for (int m = 0; m < 4; ++m) { bf16_t* qrow = Q + (size_t)(row0 + ai * HALF + m * 16) * 768;
#pragma unroll
                    for (int bj = 0; bj < 2; ++bj) {
#if TILE_Q
                        const int row = row0 + ai * HALF + m * 16;
                        NTST((char*)Q + QT_OFF(row, 2 * pn + bj, wc) + fq * 16, pack8f(acc[ai][bj][m][0], acc[ai][bj][m][1]));
#else
                        NTST(qrow + (2 * pn + bj) * 192 + 32 * wc + 8 * fq, pack8f(acc[ai][bj][m][0], acc[ai][bj][m][1]));
#endif
                    } }
            return;
        }
        float fqv[4];
#pragma unroll
        for (int i = 0; i < 4; ++i) fqv[i] = rope_inv_freq(16 * (wc & 1) + 4 * fq + i);
        int pv[2][4];
#pragma unroll
        for (int ai = 0; ai < 2; ++ai)
#pragma unroll
            for (int m = 0; m < 4; ++m) pv[ai][m] = pos[row0 + ai * HALF + m * 16];
#pragma unroll
        for (int ai = 0; ai < 2; ++ai)
#pragma unroll
            for (int m = 0; m < 4; ++m) { const int row = row0 + ai * HALF + m * 16; bf16_t* qrow = Q + (size_t)row * 768; const float pf = (float)pv[ai][m];
                float sn[4], cs[4];
#pragma unroll
                for (int i = 0; i < 4; ++i) sincos_rad(pf * fqv[i], sn[i], cs[i]);
#pragma unroll
                for (int bj = 0; bj < 2; ++bj) { const f32x4 t1 = acc[ai][bj][m][0], t2 = acc[ai][bj][m][1]; f32x4 o1, o2;
#pragma unroll
                    for (int i = 0; i < 4; ++i) { o1[i] = t1[i] * cs[i] - t2[i] * sn[i]; o2[i] = t1[i] * sn[i] + t2[i] * cs[i]; }
#if TILE_Q
                    NTST((char*)Q + QT_OFF(row, 2 * bj + (wc >> 1), 4 + (wc & 1)) + fq * 16, pack8f(o1, o2)); } }
#else
                    NTST(qrow + (2 * bj + (wc >> 1)) * 192 + 128 + 32 * (wc & 1) + 8 * fq, pack8f(o1, o2)); } }
#endif
    }
};
struct EpiKV {
    static constexpr bool PERM = true, AFTER_DRAIN = false, INIT_ACC = false, XRES = false, HAS_NARROW = false, KHOOK = false; static constexpr int KROT = 0;
    __device__ __forceinline__ bool narrow(const Unit&) const { return false; }
    __device__ __forceinline__ int nst(const Unit&) const { return 16; }
    bf16_t *KN, *VV;
    __device__ __forceinline__ void operator()(const f32x4 (&acc)[2][2][4][2], const Unit& u, int wr, int wc, int fr, int fq) const {
        const int row0 = u.pm * BM + wr * 64 + fr; const int pn = u.pn;
#pragma unroll
        for (int ai = 0; ai < 2; ++ai)
#pragma unroll
            for (int m = 0; m < 4; ++m) {
#if TILE_KV
                const int row = row0 + ai * HALF + m * 16;
                const size_t o = ((((size_t)(row >> 11) * 4 + pn) * 128 + ((row & 2047) >> 4)) * 4 + wc) * 512 + (row & 15) * 32 + fq * 8;
#else
                const size_t o = (size_t)(row0 + ai * HALF + m * 16) * 512 + pn * 128 + 32 * wc + 8 * fq;
#endif
                NTST(KN + o, pack8f(acc[ai][0][m][0], acc[ai][0][m][1]));
                NTST(VV + o, pack8f(acc[ai][1][m][0], acc[ai][1][m][1])); }
    }
};
#ifndef OUT_AUX
#define OUT_AUX NT_AUX
#endif
__device__ __forceinline__ void bstore16(u32x4 v, __amdgpu_buffer_rsrc_t r, int voff, int soff) { __builtin_amdgcn_raw_buffer_store_b128(v, r, voff + soff, 0, OUT_AUX); }
struct EpiOutLnBar {
    static constexpr bool PERM = false, AFTER_DRAIN = true, INIT_ACC = true, XRES = false, HAS_NARROW = false, KHOOK = false; static constexpr int KROT = 0;
    static constexpr float eps_s = 1e-5f / 1.4142135623730951f;
    __device__ __forceinline__ bool narrow(const Unit&) const { return false; }
    __device__ __forceinline__ int nst(const Unit&) const { return 0; }
    const float* x; float* out; const float* lng; const float* lnb; float* stat; const XcdBarrier* bar;
    __device__ __forceinline__ void init_acc(f32x4 (&acc)[2][2][4][2], const Unit& u, int wr, int wc, int fr, int fq) const {
        const __amdgpu_buffer_rsrc_t rX = __builtin_amdgcn_make_buffer_rsrc((void*)x, 0, 65536u * 1024u * 4u, 0x00020000);
        const int vo = (fr * 1024 + wc * 32 + 4 * fq) * 4; const int so0 = ((u.pm * BM + wr * 64) * 1024 + u.pn * BM) * 4;
#pragma unroll
        for (int ai = 0; ai < 2; ++ai)
#pragma unroll
            for (int bj = 0; bj < 2; ++bj)
#pragma unroll
                for (int m = 0; m < 4; ++m)
#pragma unroll
                    for (int n = 0; n < 2; ++n) acc[ai][bj][m][n] = __builtin_bit_cast(f32x4, __builtin_amdgcn_raw_buffer_load_b128(rX, vo + (bj * HALF + n * 16) * 4, so0 + (ai * HALF + m * 16) * 4096, 0));
    }
    __device__ __forceinline__ void fused(f32x4 (&acc)[2][2][4][2], const Unit& u, int wr, int wc, int fr_, int fq_, PG8_LAS unsigned char* lds, int wid, int lane_) const {
        typedef float f32x2v __attribute__((ext_vector_type(2)));
        int lane = lane_; asm volatile("" : "+v"(lane));
        const int fr = lane & 15, fq = lane >> 4;
        PG8_LAS f32x2v* S = (PG8_LAS f32x2v*)(lds + 8192);
        const __amdgpu_buffer_rsrc_t rO = __builtin_amdgcn_make_buffer_rsrc((void*)out, 0, 65536u * 1024u * 4u, 0x00020000);
        const int vo = (fr * 1024 + wc * 32 + 4 * fq) * 4;
        const int so0 = ((u.pm * BM + wr * 64) * 1024 + u.pn * BM) * 4;
#pragma unroll
        for (int ai = 0; ai < 2; ++ai)
#pragma unroll
            for (int m = 0; m < 4; ++m) { float s = 0.f, q = 0.f;
#pragma unroll
                for (int bj = 0; bj < 2; ++bj)
#pragma unroll
                    for (int n = 0; n < 2; ++n) { const f32x4 v = acc[ai][bj][m][n]; s += (v[0] + v[1]) + (v[2] + v[3]); q += (v[0] * v[0] + v[1] * v[1]) + (v[2] * v[2] + v[3] * v[3]); }
                s = rowsum4(s); q = rowsum4(q);
                if (fq == 0) *(f32x2v*)(stat + ((size_t)(u.pm * BM + ai * HALF + wr * 64 + m * 16 + fr) * 16 + u.pn * 4 + wc) * 2) = (f32x2v){s, q}; }
        xcd_barrier(*bar);
        { const int row = wid * 64 + lane;
          if (row < 256) { const f32x4* p = (const f32x4*)(stat + (size_t)(u.pm * BM + row) * 32); float s = 0.f, q = 0.f;
#pragma unroll
              for (int k = 0; k < 8; ++k) { const f32x4 t = p[k]; s += t[0] + t[2]; q += t[1] + t[3]; }
              const float mean = s * (1.0f / 1024.0f); const float var = fmaxf(q * (1.0f / 1024.0f) - mean * mean, 0.f);
              S[row] = (f32x2v){mean, 1.0f / sqrtf(var + eps_s)}; } }
        asm volatile("s_waitcnt lgkmcnt(0)" ::: "memory"); __builtin_amdgcn_s_barrier(); asm volatile("" ::: "memory");
        const int col0 = u.pn * BM + wc * 32 + 4 * fq;
#pragma unroll
        for (int bj = 0; bj < 2; ++bj)
#pragma unroll
            for (int n = 0; n < 2; ++n) { const f32x4 gv = *(const f32x4*)(lng + col0 + bj * HALF + n * 16), bv = *(const f32x4*)(lnb + col0 + bj * HALF + n * 16);
#pragma unroll
                for (int ai = 0; ai < 2; ++ai)
#pragma unroll
                    for (int m = 0; m < 4; ++m) { const int r = ai * HALF + wr * 64 + m * 16 + fr; const f32x2v sr = S[r];
                        const f32x4 o = (acc[ai][bj][m][n] - sr.x) * sr.y * gv + bv;
                        bstore16(__builtin_bit_cast(u32x4, o), rO, vo + (bj * HALF + n * 16) * 4, so0 + (ai * HALF + m * 16) * 4096); } }
    }
};
#ifdef LN_POLL
#define LN_MARK 1u
#else
#define LN_MARK 0u
#endif
constexpr int LN_TAB_OFF = 135168;
struct EpiOutLnPeer {
#ifdef FUSE34_KROT
    static constexpr bool KHOOK = true; static constexpr int KROT = 8;
#else
    static constexpr bool KHOOK = false; static constexpr int KROT = 0;
#endif
    __device__ __forceinline__ void khook(int t, const Unit& u) const {
#ifdef PROBE_P4K2
        if (u.dummy) return;
#endif
        if (t == 0) { if (threadIdx.x == 0) (void)__hip_atomic_fetch_add(pcnt + u.pm * 16, 1u, __ATOMIC_RELAXED, __HIP_MEMORY_SCOPE_AGENT); }
#ifdef PROBE_XRD
        else if (t == 8) {
            int tl = threadIdx.x; asm volatile("" : "+v"(tl)); const int wv = __builtin_amdgcn_readfirstlane(tl >> 6), ln = tl & 63;
            const char* xb = (const char*)x + ((size_t)(u.pm * BM) * 1024 + (size_t)u.pn * BM) * 4;
#pragma unroll 4
            for (int j = 0; j < 32; ++j) {
#if PROBE_XRD == 1
                const size_t off = (size_t)((wv >> 2) * 64 + (j >> 3) * 16 + (j & 1) * 128 + (ln & 15)) * 4096 + (size_t)(((j >> 1) & 3) * 64 + (wv & 3) * 32 * 4 % 1024 + (ln >> 4) * 16);
#else
                const size_t off = (size_t)(wv * 32 + j) * 4096 + (size_t)ln * 16;
#endif
                __builtin_amdgcn_global_load_lds((const unsigned*)(xb + off), (PG8_LAS unsigned*)(tab + 4096 + wv * 1024), 16, 0, 0); } }
#endif
#ifdef XRES_TOUCH
        else if (t == XRES_TOUCH) {
            int tl = threadIdx.x; asm volatile("" : "+v"(tl)); const int wv = __builtin_amdgcn_readfirstlane(tl >> 6);
            const char* xb = (const char*)x + ((size_t)(u.pm * BM) * 1024 + (size_t)u.pn * BM) * 4;
#pragma unroll
            for (int j = 0; j < 4; ++j) { const int L = tl * 4 + j; __builtin_amdgcn_global_load_lds((const unsigned*)(xb + (size_t)(L >> 3) * 4096 + (L & 7) * 128), (PG8_LAS unsigned*)(tab + 4096 + wv * 256), 4, 0, 0); } }
#endif
        else if (t == 4) { if (__builtin_amdgcn_readfirstlane((int)threadIdx.x >> 6) == 0) { unsigned sp = 0u;
            while (__hip_atomic_load(pcnt + u.pm * 16, __ATOMIC_RELAXED, __HIP_MEMORY_SCOPE_AGENT) < 4u) { __builtin_amdgcn_s_sleep(1);
                if ((++sp & 1023u) == 0u && (sp > (1u << 22) || __hip_atomic_load(tmo, __ATOMIC_RELAXED, __HIP_MEMORY_SCOPE_AGENT) != 0u)) { __hip_atomic_store(tmo, 1u, __ATOMIC_RELAXED, __HIP_MEMORY_SCOPE_AGENT); break; } } } }
    }
    static constexpr bool PERM = false, AFTER_DRAIN = false, INIT_ACC = false, XRES = true, HAS_NARROW = false;
    __device__ __forceinline__ const char* xres_ptr() const { return (const char*)x; }
    static constexpr float eps_s = 1e-5f / 1.4142135623730951f;
    __device__ __forceinline__ bool narrow(const Unit&) const { return false; }
    __device__ __forceinline__ int nst(const Unit&) const { return 0; }
    const float* x; float* out; const float* lng; const float* lnb; float* stat; unsigned* cnt; unsigned* tmo; PG8_LAS unsigned char* tab; const XcdBarrier* bar; unsigned* pcnt; int l2scope;
    __device__ __forceinline__ void init_acc(f32x4 (&acc)[2][2][4][2], const Unit& u, int wr, int wc, int fr, int fq) const {
        const __amdgpu_buffer_rsrc_t rX = __builtin_amdgcn_make_buffer_rsrc((void*)x, 0, 65536u * 1024u * 4u, 0x00020000);
        const int vo = (fr * 1024 + wc * 32 + 4 * fq) * 4; const int so0 = ((u.pm * BM + wr * 64) * 1024 + u.pn * BM) * 4;
#pragma unroll
        for (int ai = 0; ai < 2; ++ai)
#pragma unroll
            for (int bj = 0; bj < 2; ++bj)
#pragma unroll
                for (int m = 0; m < 4; ++m)
#pragma unroll
                    for (int n = 0; n < 2; ++n) { acc[ai][bj][m][n] = __builtin_bit_cast(f32x4, __builtin_amdgcn_raw_buffer_load_b128(rX, vo + (bj * HALF + n * 16) * 4, so0 + (ai * HALF + m * 16) * 4096, 0));
#ifdef PROBE_X2
                        { f32x4 dup = __builtin_bit_cast(f32x4, __builtin_amdgcn_raw_buffer_load_b128(rX, vo + (bj * HALF + n * 16) * 4, so0 + (ai * HALF + m * 16) * 4096 + 1024 * 4096, 1)); asm volatile("" :: "v"(dup)); }
#endif
                    }
    }
    __device__ __forceinline__ void operator()(const f32x4 (&acc)[2][2][4][2], const Unit& u, int wr, int wc, int fr_, int fq_) const { run(acc, u, wr, wc, 0); }
    __device__ __forceinline__ void run(const f32x4 (&acc)[2][2][4][2], const Unit& u, int wr, int wc, int cbank) const {
        typedef float f32x2v __attribute__((ext_vector_type(2)));
        if (u.dummy) return;
        int tid = threadIdx.x; asm volatile("" : "+v"(tid));
        const int lane = tid & 63, fr = lane & 15, fq = lane >> 4;
        PG8_LAS f32x2v* S = (PG8_LAS f32x2v*)tab; PG8_LAS unsigned* flag = (PG8_LAS unsigned*)(tab + 2048);
#ifdef DBG_X2
        { const __amdgpu_buffer_rsrc_t rO2 = __builtin_amdgcn_make_buffer_rsrc((void*)out, 0, 65536u * 1024u * 4u, 0x00020000); const int vo2 = (fr * 1024 + wc * 32 + 4 * fq) * 4; const int so2 = ((u.pm * BM + wr * 64) * 1024 + u.pn * BM) * 4;
          _Pragma("unroll") for (int ai = 0; ai < 2; ++ai) _Pragma("unroll") for (int m = 0; m < 4; ++m) _Pragma("unroll") for (int bj = 0; bj < 2; ++bj) _Pragma("unroll") for (int n = 0; n < 2; ++n)
            bstore16(__builtin_bit_cast(u32x4, acc[ai][bj][m][n]), rO2, vo2 + (bj * HALF + n * 16) * 4, so2 + (ai * HALF + m * 16) * 4096);
          return; }
#endif
        const __amdgpu_buffer_rsrc_t rO = __builtin_amdgcn_make_buffer_rsrc((void*)out, 0, 65536u * 1024u * 4u, 0x00020000);
#if defined(PROBE_ST2B) || defined(PROBE_ST2C) || defined(PROBE_ST2D)
        const __amdgpu_buffer_rsrc_t rOB = __builtin_amdgcn_make_buffer_rsrc((void*)((char*)stat + (28u << 20)), 0, 65536u * 1024u * 4u, 0x00020000);
#endif
        const int vo = (fr * 1024 + wc * 32 + 4 * fq) * 4;
        const int so0 = ((u.pm * BM + wr * 64) * 1024 + u.pn * BM) * 4;
        f32x4 gvv[2][2], bvv[2][2];
        { const int col0 = u.pn * BM + wc * 32 + 4 * fq;
#pragma unroll
          for (int bj = 0; bj < 2; ++bj)
#pragma unroll
              for (int n = 0; n < 2; ++n) { gvv[bj][n] = *(const f32x4*)(lng + col0 + bj * HALF + n * 16); bvv[bj][n] = *(const f32x4*)(lnb + col0 + bj * HALF + n * 16); } }
#ifdef PROBE_STAT2
        _Pragma("unroll 1") for (int rep_ = 0; rep_ < 2; ++rep_) {
#else
        {
#endif
        unsigned long long svv[2][4];
#pragma unroll
        for (int ai = 0; ai < 2; ++ai)
#pragma unroll
            for (int m = 0; m < 4; ++m) { float s = 0.f, q = 0.f;
#pragma unroll
                for (int bj = 0; bj < 2; ++bj)
#pragma unroll
                    for (int n = 0; n < 2; ++n) { const f32x4 v = acc[ai][bj][m][n]; s += (v[0] + v[1]) + (v[2] + v[3]); q += (v[0] * v[0] + v[1] * v[1]) + (v[2] * v[2] + v[3] * v[3]); }
                s = rowsum4(s); q = rowsum4(q);
                svv[ai][m] = ((unsigned long long)(__float_as_uint(q) | LN_MARK) << 32) | __float_as_uint(s); }
        if (fq == 0) { unsigned long long* sp0 = (unsigned long long*)(stat + ((size_t)(u.pm * BM + wr * 64 + fr) * 16 + u.pn * 4 + wc) * 2);
            if (l2scope) {
#pragma unroll
                for (int ai = 0; ai < 2; ++ai)
#pragma unroll
                    for (int m = 0; m < 4; ++m) __hip_atomic_store(sp0 + (size_t)(ai * HALF + m * 16) * 16, svv[ai][m], __ATOMIC_RELAXED, __HIP_MEMORY_SCOPE_WORKGROUP);
            } else {
#pragma unroll
                for (int ai = 0; ai < 2; ++ai)
#pragma unroll
                    for (int m = 0; m < 4; ++m) __hip_atomic_store(sp0 + (size_t)(ai * HALF + m * 16) * 16, svv[ai][m], __ATOMIC_RELAXED, __HIP_MEMORY_SCOPE_AGENT);
            } }
#ifndef LN_POLL
        asm volatile("s_waitcnt vmcnt(0)" ::: "memory");
#endif
        }
#ifdef LN_POLL
        if (tid == 0) flag[0] = 0u;
        if (tid < 256) { const unsigned long long* p = (const unsigned long long*)(stat + (size_t)(u.pm * BM + tid) * 32); float s = 0.f, q = 0.f; unsigned sp = 0u;
            for (;;) { unsigned long long w[16]; bool ok = true;
#pragma unroll
                for (int k = 0; k < 16; ++k) { w[k] = __hip_atomic_load(p + k, __ATOMIC_RELAXED, __HIP_MEMORY_SCOPE_AGENT); }
#pragma unroll
                for (int k = 0; k < 16; ++k) ok = ok && ((unsigned)(w[k] >> 32) != 0u);
                if (ok) { s = 0.f; q = 0.f;
#pragma unroll
                    for (int k = 0; k < 16; ++k) { s += __uint_as_float((unsigned)w[k]); q += __uint_as_float((unsigned)(w[k] >> 32)); }
                    break; }
                __builtin_amdgcn_s_sleep(1);
                if ((++sp & 255u) == 0u && (sp > (1u << 20) || __hip_atomic_load(tmo, __ATOMIC_RELAXED, __HIP_MEMORY_SCOPE_AGENT) != 0u)) { __hip_atomic_store(tmo, 1u, __ATOMIC_RELAXED, __HIP_MEMORY_SCOPE_AGENT); flag[0] = 1u; break; } }
            const float mean = s * (1.0f / 1024.0f); const float var = fmaxf(q * (1.0f / 1024.0f) - mean * mean, 0.f);
            S[tid] = (f32x2v){mean, 1.0f / sqrtf(var + eps_s)}; }
        asm volatile("s_waitcnt lgkmcnt(0)" ::: "memory"); __builtin_amdgcn_s_barrier(); asm volatile("" ::: "memory");
        const bool bad = flag[0] != 0u; const float qnan = __builtin_nanf("");
#else
        __builtin_amdgcn_s_barrier(); asm volatile("" ::: "memory");
#ifdef DBG_NOPEER
        if (tid == 0) flag[0] = 0u;
#else
        if (tid == 0) {
            unsigned* c = cnt + 64 * u.pm + cbank * (2 * 256 * 64);
            (void)__hip_atomic_fetch_add(c, 1u, __ATOMIC_RELAXED, __HIP_MEMORY_SCOPE_AGENT);
            unsigned sp = 0u, dead = 0u;
            while (__hip_atomic_load(c, __ATOMIC_RELAXED, __HIP_MEMORY_SCOPE_AGENT) < 4u) { __builtin_amdgcn_s_sleep(2);
                if ((++sp & 1023u) == 0u) { if (sp > (1u << 20) || __hip_atomic_load(tmo, __ATOMIC_RELAXED, __HIP_MEMORY_SCOPE_AGENT) != 0u) { __hip_atomic_store(tmo, 1u, __ATOMIC_RELAXED, __HIP_MEMORY_SCOPE_AGENT); dead = 1u; break; } } }
#ifdef PROBE_POLL2
            for (int k_ = 0; k_ < 8; ++k_) { if (__hip_atomic_load(c, __ATOMIC_RELAXED, __HIP_MEMORY_SCOPE_AGENT) < 4u) dead = 1u; }
#endif
            flag[0] = dead;
        }
#endif
        asm volatile("s_waitcnt lgkmcnt(0)" ::: "memory"); __builtin_amdgcn_s_barrier(); asm volatile("" ::: "memory");
#ifdef DBG_EXTRA_GRIDBAR
        xcd_barrier(*bar);
#endif
#ifdef PROBE_RD2
        _Pragma("unroll 1") for (int rep_ = 0; rep_ < 2; ++rep_)
#endif
#ifdef LN_SLOTS_WIDE
        { const __amdgpu_buffer_rsrc_t rS = __builtin_amdgcn_make_buffer_rsrc((void*)stat, 0, 65536u * 128u, 0x00020000);
          const int sv = (tid >> 1) * 128 + (tid & 1) * 64, ss = u.pm * BM * 128;
          u32x4 w0, w1, w2, w3;
          if (l2scope) { w0 = __builtin_amdgcn_raw_buffer_load_b128(rS, sv + ss, 0, 1); w1 = __builtin_amdgcn_raw_buffer_load_b128(rS, sv + ss + 16, 0, 1); w2 = __builtin_amdgcn_raw_buffer_load_b128(rS, sv + ss + 32, 0, 1); w3 = __builtin_amdgcn_raw_buffer_load_b128(rS, sv + ss + 48, 0, 1); }
          else { w0 = __builtin_amdgcn_raw_buffer_load_b128(rS, sv + ss, 0, 16); w1 = __builtin_amdgcn_raw_buffer_load_b128(rS, sv + ss + 16, 0, 16); w2 = __builtin_amdgcn_raw_buffer_load_b128(rS, sv + ss + 32, 0, 16); w3 = __builtin_amdgcn_raw_buffer_load_b128(rS, sv + ss + 48, 0, 16); }
          float s = ((__uint_as_float(w0.x) + __uint_as_float(w0.z)) + (__uint_as_float(w1.x) + __uint_as_float(w1.z))) + ((__uint_as_float(w2.x) + __uint_as_float(w2.z)) + (__uint_as_float(w3.x) + __uint_as_float(w3.z)));
          float q = ((__uint_as_float(w0.y) + __uint_as_float(w0.w)) + (__uint_as_float(w1.y) + __uint_as_float(w1.w))) + ((__uint_as_float(w2.y) + __uint_as_float(w2.w)) + (__uint_as_float(w3.y) + __uint_as_float(w3.w)));
          s += __shfl_xor(s, 1); q += __shfl_xor(q, 1);
          if ((tid & 1) == 0) { const float mean = s * (1.0f / 1024.0f); const float var = fmaxf(q * (1.0f / 1024.0f) - mean * mean, 0.f);
              S[tid >> 1] = (f32x2v){mean, 1.0f / sqrtf(var + eps_s)}; } }
#else
        if (tid < 256) { const unsigned long long* p = (const unsigned long long*)(stat + (size_t)(u.pm * BM + tid) * 32); float s = 0.f, q = 0.f;
#pragma unroll
            for (int k = 0; k < 16; ++k) { const unsigned long long w = __hip_atomic_load(p + k, __ATOMIC_RELAXED, __HIP_MEMORY_SCOPE_AGENT); s += __uint_as_float((unsigned)w); q += __uint_as_float((unsigned)(w >> 32)); }
            const float mean = s * (1.0f / 1024.0f); const float var = fmaxf(q * (1.0f / 1024.0f) - mean * mean, 0.f);
            S[tid] = (f32x2v){mean, 1.0f / sqrtf(var + eps_s)}; }
#endif
        asm volatile("s_waitcnt lgkmcnt(0)" ::: "memory"); __builtin_amdgcn_s_barrier(); asm volatile("" ::: "memory");
        const bool bad = flag[0] != 0u; const float qnan = __builtin_nanf("");
#endif
#ifdef LN_ROWSTORE
        { PG8_LAS unsigned char* T = tab - LN_TAB_OFF; constexpr int RP = 1040;
          const int wv8 = __builtin_amdgcn_readfirstlane(tid >> 6);
          const int wbase = (wr * 64 + fr) * RP + (wc * 32 + 4 * fq) * 4;
          const f32x4 qn4 = (f32x4){qnan, qnan, qnan, qnan};
#pragma unroll
          for (int ai = 0; ai < 2; ++ai) {
#pragma unroll
              for (int m = 0; m < 4; ++m) { const f32x2v sr = S[ai * HALF + wr * 64 + m * 16 + fr];
#pragma unroll
                  for (int bj = 0; bj < 2; ++bj)
#pragma unroll
                      for (int n = 0; n < 2; ++n) { f32x4 o = (acc[ai][bj][m][n] - sr.x) * sr.y * gvv[bj][n] + bvv[bj][n]; if (bad) o = qn4;
                          *(PG8_LAS f32x4*)(T + wbase + m * 16 * RP + (bj * HALF + n * 16) * 4) = o; } }
              asm volatile("s_waitcnt lgkmcnt(0)" ::: "memory"); __builtin_amdgcn_s_barrier(); asm volatile("" ::: "memory");
#pragma unroll
              for (int j = 0; j < 16; ++j) { const int rr = wv8 * 16 + j; const u32x4 v = *(const PG8_LAS u32x4*)(T + rr * RP + lane * 16);
                  bstore16(v, rO, lane * 16, ((u.pm * BM + ai * HALF + rr) * 1024 + u.pn * BM) * 4); }
              if (ai == 0) { asm volatile("s_waitcnt lgkmcnt(0)" ::: "memory"); __builtin_amdgcn_s_barrier(); asm volatile("" ::: "memory"); }
          } }
#elif defined(LN_ST128)
        { const int voA = ((fr & 7) * 1024 + wc * 32 + 4 * fq + 16 * (fr >> 3)) * 4;
#pragma unroll
          for (int bj = 0; bj < 2; ++bj) { const f32x4 g0 = gvv[bj][0], g1 = gvv[bj][1], b0 = bvv[bj][0], b1 = bvv[bj][1];
#pragma unroll
            for (int ai = 0; ai < 2; ++ai)
#pragma unroll
                for (int m = 0; m < 4; ++m) { const int r = ai * HALF + wr * 64 + m * 16 + fr; const f32x2v sr = S[r];
                    f32x4 o0 = (acc[ai][bj][m][0] - sr.x) * sr.y * g0 + b0, o1 = (acc[ai][bj][m][1] - sr.x) * sr.y * g1 + b1;
                    if (bad) { o0 = (f32x4){qnan, qnan, qnan, qnan}; o1 = o0; }
                    u32x4 A, B; const u32x4 u0 = __builtin_bit_cast(u32x4, o0), u1 = __builtin_bit_cast(u32x4, o1);
#pragma unroll
                    for (int c = 0; c < 4; ++c) { A[c] = (unsigned)__builtin_amdgcn_update_dpp((int)u0[c], (int)u1[c], 0x128, 0xF, 0xC, false);
                                                  B[c] = (unsigned)__builtin_amdgcn_update_dpp((int)u1[c], (int)u0[c], 0x128, 0xF, 0x3, false); }
                    bstore16(A, rO, voA + (bj * HALF) * 4, so0 + (ai * HALF + m * 16) * 4096);
                    bstore16(B, rO, voA + (bj * HALF) * 4, so0 + (ai * HALF + m * 16 + 8) * 4096); } } }
#else
#ifdef PROBE_FIN2
        _Pragma("unroll 1") for (int rep_ = 0; rep_ < 2; ++rep_)
#endif
#pragma unroll
        for (int bj = 0; bj < 2; ++bj)
#pragma unroll
            for (int n = 0; n < 2; ++n) { const f32x4 gv = gvv[bj][n], bv = bvv[bj][n];
#pragma unroll
                for (int ai = 0; ai < 2; ++ai)
#pragma unroll
                    for (int m = 0; m < 4; ++m) { const int r = ai * HALF + wr * 64 + m * 16 + fr; const f32x2v sr = S[r];
#if defined(DBG_X3)
                        f32x4 o = acc[ai][bj][m][n];
#elif defined(DBG_X4)
                        f32x4 o = acc[ai][bj][m][n] + (sr.x - sr.x);
#elif defined(DBG_X5)
                        f32x4 o = acc[ai][bj][m][n] + ((__builtin_fabsf(sr.x) < 1e30f) ? 0.f : 100.f);
#elif defined(DBG_X6)
                        f32x4 o = acc[ai][bj][m][n] + ((__builtin_fabsf(sr.x) < 10.f) ? 0.f : 100.f);
#else
                        f32x4 o = (acc[ai][bj][m][n] - sr.x) * sr.y * gv + bv; if (bad) o = (f32x4){qnan, qnan, qnan, qnan};
#endif
                        bstore16(__builtin_bit_cast(u32x4, o), rO, vo + (bj * HALF + n * 16) * 4, so0 + (ai * HALF + m * 16) * 4096);
#ifdef PROBE_ST2
                        bstore16(__builtin_bit_cast(u32x4, o), rO, vo + (bj * HALF + n * 16) * 4, so0 + (ai * HALF + m * 16) * 4096);
#endif
#ifdef PROBE_ST2D
                        bstore16(__builtin_bit_cast(u32x4, o), rOB, (fr + 16 * fq) * 16, so0 + ((ai * 4 + m) * 4 + bj * 2 + n) * 1024 + wc * 32768);
#endif
#ifdef PROBE_ST2C
                        bstore16(__builtin_bit_cast(u32x4, o), rOB, (((fr & 7) * 1024 + wc * 32 + 4 * fq + 16 * (fr >> 3)) * 4) + (bj * HALF) * 4, so0 + (ai * HALF + m * 16 + 8 * n) * 4096);
#endif
#ifdef PROBE_ST2B
                        bstore16(__builtin_bit_cast(u32x4, o), rOB, vo + (bj * HALF + n * 16) * 4, so0 + (ai * HALF + m * 16) * 4096);
#endif
                    } }
#endif
        asm volatile("s_waitcnt lgkmcnt(0)" ::: "memory"); __builtin_amdgcn_s_barrier(); asm volatile("" ::: "memory");
    }
};
struct RoundOrder : StaticOrder {
    int round;
    __host__ __device__ void init(int M, int N, int G_, int c_, int round_) { StaticOrder::init(M, N, G_, c_); round = round_; }
    __host__ __device__ bool next(int i, Unit& u) const { if (i != 0) return false; return StaticOrder::next(round, u); }
};
struct DupOrder : StaticOrder {
    __host__ __device__ bool next(int i, Unit& u) const { const bool ok = StaticOrder::next(i >> 1, u); u.dummy = (i & 1) ? 0 : 1; return ok; }
};
struct RotOrder : StaticOrder {
    __host__ __device__ bool next(int i, Unit& u) const { const int s = (i == 2) ? 8 : (i == 4) ? 16 : (i == 7) ? 24 : 0; StaticOrder t = *this; t.c = (c & 7) | ((((c >> 3) + s) & 31) << 3); return t.next(i, u); }
};
struct AbOrder {
    static constexpr bool SINGLE = false;
    int c, nr;
    __device__ void init(int, int N, int, int c_) { c = c_; nr = N / BM; asm volatile("" : "+s"(nr)); }
    __device__ bool next(int i, Unit& u) const { if (i >= nr) return false; const int xcd = c & 7, k = c >> 3, grp = k & 1, j = k >> 1;
        u.pm = 8 * (4 * xcd + (j >> 2)) + 4 * grp + i; u.pn = j & 3; u.dummy = 0; return true; }
    __device__ __forceinline__ void a_ready(const Unit&) const {}
    __device__ __forceinline__ void done(const Unit&) const {}
};
struct OneOrder {
#ifdef ONE_TRIM
    static constexpr bool SINGLE = true;
#else
    static constexpr bool SINGLE = false;
#endif
    int pm, pn, n1, dum;
    __device__ void init(int pm_, int pn_, int dum_ = 0) { pm = pm_; pn = pn_; n1 = 1; dum = dum_; asm volatile("" : "+s"(n1)); }
    __device__ bool next(int i, Unit& u) const { if (i >= n1) return false; u.pm = pm; u.pn = pn; u.dummy = dum; return true; }
    __device__ __forceinline__ void a_ready(const Unit&) const {}
    __device__ __forceinline__ void done(const Unit&) const {}
};
struct NfOrder {
    static constexpr bool SINGLE = false;
    int c, nr;
    __device__ void init(int, int N, int, int c_) { c = c_; nr = N / BM; asm volatile("" : "+s"(nr)); }
    __device__ bool next(int i, Unit& u) const { if (i >= nr) return false; const int xcd = c & 7, k = c >> 3, cls = k & 1, cc = k >> 1, base = 32 * xcd + 16 * cls;
        const bool nar = cls ? (i == 0) : (i == nr - 1); const int sl = cls ? i - 1 : i;
        if (nar) { u.pm = base + cc; u.pn = nr - 1; }
        else { const int j = 16 * sl + cc, grp = j / 36, w = j - 36 * grp; u.pm = base + 4 * grp + (w & 3); u.pn = w >> 2; }
        u.dummy = 0; return true; }
    __device__ __forceinline__ void a_ready(const Unit&) const {}
    __device__ __forceinline__ void done(const Unit&) const {}
};
struct RevOrder : StaticOrder {
    __host__ __device__ bool next(int i, Unit& u) const { const bool ok = StaticOrder::next(i, u); u.pm = (u.pm & ~31) | (31 - (u.pm & 31)); return ok; }
};
template <class Epi, class Sched, bool ALIGN_EPI = false, bool SP2 = false>
__device__ __forceinline__ void gemm_phase(PG8_LAS unsigned char* lds, const Gemm g, const Sched& S, const Epi& E) {
    int tid_ = threadIdx.x; asm volatile("" : "+v"(tid_));
    const int tid = tid_, wid = __builtin_amdgcn_readfirstlane(tid >> 6), lane = tid & 63, wr = wid >> 2, wc = wid & 3, fr = lane & 15, fq = lane >> 4;
    const int K = g.K, nt = K / BK;
    unsigned voffA[2], voffB[2];
#pragma unroll
    for (int i = 0; i < 2; ++i) { int R, C; stage_rc(tid * 16 + i * 8192, R, C); const int Rb = Epi::PERM ? ((R & ~31) + perm32(R & 31)) : R;
        voffA[i] = g.tiledA ? (unsigned)(((R >> 4) * (K >> 5) + (C >> 5)) * 1024 + (R & 15) * 64 + (C & 31) * 2) : (unsigned)(R * K + C) * 2u; voffB[i] = (unsigned)(Rb * K + C) * 2u; }
    const size_t kstep = (size_t)(BK * 2);
    const size_t kstepA = g.tiledA ? (size_t)2048 : kstep;
    const size_t hstep = (size_t)HALF * K * 2;
    const size_t tstep = 2 * hstep;
    const unsigned ldsw = (unsigned)wid * 1024u;
    const int aoff = lds_byte(wr * 64 + fr, fq * 8), boff = lds_byte(wc * 32 + fr, fq * 8);
#define PG8_SA(b, h) (((b) * 2 + (h)) * HTB)
#define PG8_SB(b, h) ((4 + (b) * 2 + (h)) * HTB)
#define PG8_STAGE(bufoff, gbase, voff) do { _Pragma("unroll") for (int _i = 0; _i < 2; ++_i) \
        __builtin_amdgcn_global_load_lds((const unsigned*)((const char*)(gbase) + (voff)[_i]), (PG8_LAS unsigned*)(lds + (bufoff) + ldsw + _i * 8192), 16, 0, 0); } while (0)
#ifdef XRES_ROWS
#define PG8_STAGE_X(bufoff, gsb) do { int tl_ = tid; asm volatile("" : "+v"(tl_)); const int r8_ = (tl_ & 63) >> 3, s_ = tl_ & 7; \
        const unsigned vox0 = (unsigned)(((r8_ * 1024) + wc * 32 + 4 * ((s_ - (r8_ >> 1)) & 7)) * 4), vox1 = (unsigned)((((8 + r8_) * 1024) + wc * 32 + 4 * ((s_ - ((8 + r8_) >> 1)) & 7)) * 4); \
        __builtin_amdgcn_global_load_lds((const unsigned*)((gsb) + vox0), (PG8_LAS unsigned*)(lds + (bufoff) + ldsw), 16, 0, RDX_AUX); \
        __builtin_amdgcn_global_load_lds((const unsigned*)((gsb) + vox1), (PG8_LAS unsigned*)(lds + (bufoff) + ldsw + 8192), 16, 0, RDX_AUX); } while (0)
#define PG8_XRD(dst, bufoff) do { const int fr_ = lane & 15, fq_ = lane >> 4; const int o0_ = (fr_ >> 3) * 8192 + ((fr_ & 7) * 8 + ((fq_ + (fr_ >> 1)) & 7)) * 16; \
        dst[0] = *(const PG8_LAS f32x4*)(lds + (bufoff) + ldsw + o0_); dst[1] = *(const PG8_LAS f32x4*)(lds + (bufoff) + ldsw + (o0_ ^ 64)); } while (0)
#else
#define PG8_STAGE_X(bufoff, gsb) do { int tl_ = tid; asm volatile("" : "+v"(tl_)); const unsigned vox0 = (unsigned)((((tl_ & 15) * 1024) + wc * 32 + 4 * ((tl_ & 63) >> 4)) * 4), vox1 = vox0 + 64u; \
        __builtin_amdgcn_global_load_lds((const unsigned*)((gsb) + vox0), (PG8_LAS unsigned*)(lds + (bufoff) + ldsw), 16, 0, RDX_AUX); \
        __builtin_amdgcn_global_load_lds((const unsigned*)((gsb) + vox1), (PG8_LAS unsigned*)(lds + (bufoff) + ldsw + 8192), 16, 0, RDX_AUX); } while (0)
#define PG8_XRD(dst, bufoff) do { dst[0] = *(const PG8_LAS f32x4*)(lds + (bufoff) + ldsw + lane * 16); dst[1] = *(const PG8_LAS f32x4*)(lds + (bufoff) + ldsw + 8192 + lane * 16); } while (0)
#endif
#define PG8_LDA(dst, b, h) do { _Pragma("unroll") for (int m = 0; m < 4; ++m) _Pragma("unroll") for (int k = 0; k < 2; ++k) dst[m][k] = *(const PG8_LAS bf16x8*)(lds + PG8_SA(b, h) + aoff + m * 2048 + k * 1024); } while (0)
#define PG8_LDB(dst, b, h) do { _Pragma("unroll") for (int n = 0; n < 2; ++n) _Pragma("unroll") for (int k = 0; k < 2; ++k) dst[n][k] = *(const PG8_LAS bf16x8*)(lds + PG8_SB(b, h) + boff + n * 2048 + k * 1024); } while (0)
#define PG8_MMA(ai, bj, At, Bt) do { __builtin_amdgcn_s_setprio(1); _Pragma("unroll") for (int m = 0; m < 4; ++m) _Pragma("unroll") for (int n = 0; n < 2; ++n) _Pragma("unroll") for (int k = 0; k < 2; ++k) \
        acc[ai][bj][m][n] = __builtin_amdgcn_mfma_f32_16x16x32_bf16(Bt[n][k], At[m][k], acc[ai][bj][m][n], 0, 0, 0); __builtin_amdgcn_s_setprio(0); } while (0)
#define PG8_WAIT_V(n) asm volatile("s_waitcnt vmcnt(" #n ")" ::: "memory")
#define PG8_WAIT_L(n) asm volatile("s_waitcnt lgkmcnt(" #n ")" ::: "memory")
#define PG8_BAR __builtin_amdgcn_s_barrier()
#define PG8_SCHED __builtin_amdgcn_sched_barrier(0)
    constexpr int KR = Epi::KROT;
#define PG8_KOFF(i) ((size_t)(KR ? (((i) + KR) & (2 * KR - 1)) : (i)) * kstep)
#define PG8_KOFFA(i) ((size_t)(KR ? (((i) + KR) & (2 * KR - 1)) : (i)) * kstepA)
    Unit cur, nxt; int ui = 0;
    if (!S.next(0, cur)) return;
    f32x4 acc[2][2][4][2];
    if constexpr (Epi::INIT_ACC) E.init_acc(acc, cur, wr, wc, fr, fq);
    else {
#pragma unroll
    for (int a = 0; a < 2; ++a)
#pragma unroll
        for (int b = 0; b < 2; ++b)
#pragma unroll
            for (int m = 0; m < 4; ++m)
#pragma unroll
                for (int n = 0; n < 2; ++n) acc[a][b][m][n] = (f32x4){0.f, 0.f, 0.f, 0.f};
    }
    bf16x8 At[4][2], B0[2][2], B1[2][2];
    const char* cA = (const char*)g.A + (size_t)cur.pm * tstep; const char* cB = (const char*)g.Bt + (size_t)cur.pn * tstep;
    S.a_ready(cur);
    const char* pA0 = cA + PG8_KOFFA(0); const char* pB0 = cB + PG8_KOFF(0); const char* pA1 = cA + PG8_KOFFA(1); const char* pB1 = cB + PG8_KOFF(1);
    if constexpr (KR != 0) asm volatile("" : "+s"(pA0), "+s"(pB0), "+s"(pA1), "+s"(pB1));
    if constexpr (SP2) {
        PG8_STAGE(PG8_SB(0, 0), pB0, voffB); PG8_STAGE(PG8_SB(0, 1), pB0 + hstep, voffB); PG8_STAGE(PG8_SA(0, 0), pA0, voffA); PG8_STAGE(PG8_SA(0, 1), pA0 + hstep, voffA);
        if (wr == 1) PG8_BAR;
        PG8_WAIT_V(2); PG8_BAR;
        PG8_STAGE(PG8_SB(1, 0), pB1, voffB); PG8_STAGE(PG8_SA(1, 0), pA1, voffA); PG8_STAGE(PG8_SB(1, 1), pB1 + hstep, voffB);
        PG8_WAIT_V(6); PG8_BAR;
    } else {
        PG8_STAGE(PG8_SB(0, 0), pB0, voffB); PG8_STAGE(PG8_SA(0, 0), pA0, voffA); PG8_STAGE(PG8_SB(0, 1), pB0 + hstep, voffB); PG8_STAGE(PG8_SA(0, 1), pA0 + hstep, voffA);
        if (wr == 1) PG8_BAR;
        PG8_WAIT_V(4); PG8_BAR;
        PG8_STAGE(PG8_SB(1, 0), pB1, voffB); PG8_STAGE(PG8_SA(1, 0), pA1, voffA); PG8_STAGE(PG8_SB(1, 1), pB1 + hstep, voffB);
        PG8_WAIT_V(6); PG8_BAR;
    }
    int pend = 0;
    for (;;) {
        const bool has_next = S.next(ui + 1, nxt);
        const char* xs = nullptr; if constexpr (Epi::XRES) xs = E.xres_ptr() + ((size_t)(cur.pm * BM + wr * 64) * 1024 + (size_t)cur.pn * BM) * 4;
        constexpr size_t XM = 16 * 4096, XC = 128 * 4, XR = 128 * 4096;
        const bool nar = E.narrow(cur);
        const char* nA = has_next ? (const char*)g.A + (size_t)nxt.pm * tstep : cA; const char* nB = has_next ? (const char*)g.Bt + (size_t)nxt.pn * tstep : cB;
        const char* nA0 = nA + PG8_KOFFA(0); const char* nB0 = nB + PG8_KOFF(0);
        if constexpr (KR != 0) asm volatile("" : "+s"(nA0), "+s"(nB0));
#define PG8_PAIR(NARROW, XLAST) do { \
            const bool last = (t == nt - 2); \
            if constexpr (Epi::KHOOK) E.khook(t, cur); \
            const char* a1 = cA + PG8_KOFFA(t + 1); \
            const char* a2 = last ? nA0 : cA + PG8_KOFFA(t + 2); const char* b2 = last ? nB0 : cB + PG8_KOFF(t + 2); \
            const char* a3 = a2 + kstepA; const char* b3 = b2 + kstep; \
            if (!Epi::XRES && last && has_next) S.a_ready(nxt); \
              \
            PG8_LDB(B0, 0, 0); PG8_LDB(B1, 0, 1); PG8_SCHED; PG8_LDA(At, 0, 0); PG8_STAGE(PG8_SA(1, 1), a1 + hstep, voffA); \
            PG8_WAIT_V(8); PG8_WAIT_L(0); PG8_BAR; PG8_MMA(0, 0, At, B0); if constexpr (!(NARROW)) PG8_MMA(0, 1, At, B1); PG8_BAR; PG8_SCHED; \
              \
            PG8_LDA(At, 0, 1); \
            if constexpr (XLAST) { PG8_STAGE_X(PG8_SB(0, 0), xs + 2 * XM); PG8_STAGE_X(PG8_SB(0, 1), xs + 3 * XM); PG8_STAGE_X(PG8_SA(0, 0), xs); } \
            else { PG8_STAGE(PG8_SB(0, 0), b2, voffB); PG8_STAGE(PG8_SB(0, 1), b2 + hstep, voffB); PG8_STAGE(PG8_SA(0, 0), a2, voffA); } \
            PG8_WAIT_V(8); PG8_WAIT_L(0); PG8_BAR; PG8_MMA(1, 0, At, B0); if constexpr (!(NARROW)) PG8_MMA(1, 1, At, B1); PG8_BAR; PG8_SCHED; \
              \
            PG8_LDB(B0, 1, 0); PG8_LDB(B1, 1, 1); PG8_SCHED; PG8_LDA(At, 1, 0); \
            if constexpr (XLAST) PG8_STAGE_X(PG8_SA(0, 1), xs + XM); else PG8_STAGE(PG8_SA(0, 1), a2 + hstep, voffA); \
            PG8_WAIT_V(8); PG8_WAIT_L(0); PG8_BAR; PG8_MMA(0, 0, At, B0); if constexpr (!(NARROW)) PG8_MMA(0, 1, At, B1); PG8_BAR; PG8_SCHED; \
              \
            PG8_LDA(At, 1, 1); \
            if constexpr (XLAST) { PG8_STAGE_X(PG8_SB(1, 0), xs + XC + 2 * XM); PG8_STAGE_X(PG8_SB(1, 1), xs + XC + 3 * XM); PG8_STAGE_X(PG8_SA(1, 0), xs + XC); } \
            else { PG8_STAGE(PG8_SB(1, 0), b3, voffB); PG8_STAGE(PG8_SB(1, 1), b3 + hstep, voffB); PG8_STAGE(PG8_SA(1, 0), a3, voffA); } \
            PG8_WAIT_V(8); PG8_WAIT_L(0); PG8_BAR; PG8_MMA(1, 0, At, B0); if constexpr (!(NARROW)) PG8_MMA(1, 1, At, B1); PG8_BAR; PG8_SCHED; } while (0)
        static_assert(SP2, "this build keeps only the two-super-phase K-loop");
        if (Epi::HAS_NARROW && nar) {
#pragma unroll 1
            for (int t = 0; t < nt; t += 2) PG8_PAIR(true, false);
        } else if constexpr (Epi::XRES) {
#pragma unroll 1
            for (int t = 0; t < nt - 2; t += 2) PG8_PAIR(false, false);
            { const int t = nt - 2; PG8_PAIR(false, true); }
        } else {
#pragma unroll 1
            for (int t = 0; t < nt; t += 2) PG8_PAIR(false, false);
        }
#undef PG8_PAIR
        if constexpr (Epi::XRES && SP2) {
            f32x4 xr0[2], xr1[2], xr2[2];
#define PG8_XADD(ai, bj, m, src) do { acc[ai][bj][m][0] = acc[ai][bj][m][0] + src[0]; acc[ai][bj][m][1] = acc[ai][bj][m][1] + src[1]; \
                asm volatile("" : "+v"(acc[ai][bj][m][0]), "+v"(acc[ai][bj][m][1])); } while (0)
            PG8_XRD(xr0, PG8_SB(0, 0)); PG8_XRD(xr1, PG8_SB(0, 1)); PG8_XRD(xr2, PG8_SA(0, 0)); PG8_STAGE_X(PG8_SA(1, 1), xs + XC + XM);
            PG8_WAIT_V(8); PG8_WAIT_L(0); PG8_BAR; PG8_XADD(0, 0, 2, xr0); PG8_XADD(0, 0, 3, xr1); PG8_XADD(0, 0, 0, xr2); PG8_BAR; PG8_SCHED;
            PG8_XRD(xr0, PG8_SA(0, 1)); PG8_STAGE_X(PG8_SB(0, 0), xs + XR + 2 * XM); PG8_STAGE_X(PG8_SB(0, 1), xs + XR + 3 * XM); PG8_STAGE_X(PG8_SA(0, 0), xs + XR);
            PG8_WAIT_V(8); PG8_WAIT_L(0); PG8_BAR; PG8_XADD(0, 0, 1, xr0); PG8_BAR; PG8_SCHED;
            PG8_XRD(xr0, PG8_SB(1, 0)); PG8_XRD(xr1, PG8_SB(1, 1)); PG8_XRD(xr2, PG8_SA(1, 0)); PG8_STAGE_X(PG8_SA(0, 1), xs + XR + XM);
            PG8_WAIT_V(8); PG8_WAIT_L(0); PG8_BAR; PG8_XADD(0, 1, 2, xr0); PG8_XADD(0, 1, 3, xr1); PG8_XADD(0, 1, 0, xr2); PG8_BAR; PG8_SCHED;
            PG8_XRD(xr0, PG8_SA(1, 1)); PG8_STAGE_X(PG8_SB(1, 0), xs + XR + XC + 2 * XM); PG8_STAGE_X(PG8_SB(1, 1), xs + XR + XC + 3 * XM); PG8_STAGE_X(PG8_SA(1, 0), xs + XR + XC);
            PG8_WAIT_V(8); PG8_WAIT_L(0); PG8_BAR; PG8_XADD(0, 1, 1, xr0); PG8_BAR; PG8_SCHED;
            if (has_next) S.a_ready(nxt);
            PG8_XRD(xr0, PG8_SB(0, 0)); PG8_XRD(xr1, PG8_SB(0, 1)); PG8_XRD(xr2, PG8_SA(0, 0)); PG8_STAGE_X(PG8_SA(1, 1), xs + XR + XC + XM);
            PG8_WAIT_V(8); PG8_WAIT_L(0); PG8_BAR; PG8_XADD(1, 0, 2, xr0); PG8_XADD(1, 0, 3, xr1); PG8_XADD(1, 0, 0, xr2); PG8_BAR; PG8_SCHED;
            if constexpr (Sched::SINGLE) {
            PG8_XRD(xr0, PG8_SA(0, 1));
            PG8_WAIT_V(2); PG8_WAIT_L(0); PG8_BAR; PG8_XADD(1, 0, 1, xr0); PG8_BAR; PG8_SCHED;
            PG8_XRD(xr0, PG8_SB(1, 0)); PG8_XRD(xr1, PG8_SB(1, 1)); PG8_XRD(xr2, PG8_SA(1, 0));
            PG8_WAIT_V(0); PG8_WAIT_L(0); PG8_BAR; PG8_XADD(1, 1, 2, xr0); PG8_XADD(1, 1, 3, xr1); PG8_XADD(1, 1, 0, xr2); PG8_BAR; PG8_SCHED;
            PG8_XRD(xr0, PG8_SA(1, 1));
            PG8_WAIT_L(0); PG8_BAR; PG8_XADD(1, 1, 1, xr0); PG8_BAR; PG8_SCHED;
            } else {
            PG8_XRD(xr0, PG8_SA(0, 1)); PG8_STAGE(PG8_SB(0, 0), nB0, voffB); PG8_STAGE(PG8_SB(0, 1), nB0 + hstep, voffB); PG8_STAGE(PG8_SA(0, 0), nA0, voffA);
            PG8_WAIT_V(8); PG8_WAIT_L(0); PG8_BAR; PG8_XADD(1, 0, 1, xr0); PG8_BAR; PG8_SCHED;
            PG8_XRD(xr0, PG8_SB(1, 0)); PG8_XRD(xr1, PG8_SB(1, 1)); PG8_XRD(xr2, PG8_SA(1, 0)); PG8_STAGE(PG8_SA(0, 1), nA0 + hstep, voffA);
            PG8_WAIT_V(8); PG8_WAIT_L(0); PG8_BAR; PG8_XADD(1, 1, 2, xr0); PG8_XADD(1, 1, 3, xr1); PG8_XADD(1, 1, 0, xr2); PG8_BAR; PG8_SCHED;
            PG8_XRD(xr0, PG8_SA(1, 1)); PG8_STAGE(PG8_SB(1, 0), nB0 + kstep, voffB); PG8_STAGE(PG8_SB(1, 1), nB0 + hstep + kstep, voffB); PG8_STAGE(PG8_SA(1, 0), nA0 + kstepA, voffA);
            PG8_WAIT_V(8); PG8_WAIT_L(0); PG8_BAR; PG8_XADD(1, 1, 1, xr0); PG8_BAR; PG8_SCHED;
            }
#undef PG8_XADD
        }
        if constexpr (ALIGN_EPI) { if (wr == 0) PG8_BAR; }
        if constexpr (!Epi::AFTER_DRAIN) { E(acc, cur, wr, wc, fr, fq);
#ifdef PROBE_E2
            if constexpr (Epi::INIT_ACC || Epi::XRES) { asm volatile("" ::: "memory"); E.run(acc, cur, wr, wc, 1); }
#endif
#ifdef PROBE_EPI2
            if constexpr (!Epi::INIT_ACC && !Epi::XRES && (PROBE_EPI2 == 3 || Epi::HAS_NARROW == (PROBE_EPI2 == 1))) { asm volatile("" ::: "memory"); E(acc, cur, wr, wc, fr, fq); }
#endif
            S.done(cur); pend = E.nst(cur); }
        if (!has_next) break;
        if constexpr (Epi::INIT_ACC) E.init_acc(acc, nxt, wr, wc, fr, fq);
        else {
#pragma unroll
        for (int a = 0; a < 2; ++a)
#pragma unroll
            for (int b = 0; b < 2; ++b)
#pragma unroll
                for (int m = 0; m < 4; ++m)
#pragma unroll
                    for (int n = 0; n < 2; ++n) acc[a][b][m][n] = (f32x4){0.f, 0.f, 0.f, 0.f};
        }
        cur = nxt; cA = nA; cB = nB; ++ui;
        if constexpr (ALIGN_EPI) { if (wr == 1) PG8_BAR; }
    }
    if constexpr (!Sched::SINGLE) PG8_WAIT_V(0);
    if constexpr (!ALIGN_EPI) { if (wr == 0) PG8_BAR; }
    PG8_BAR;
    if constexpr (Epi::AFTER_DRAIN) { E.fused(acc, cur, wr, wc, fr, fq, lds, wid, lane); S.done(cur); }
#undef PG8_SA
#undef PG8_SB
#undef PG8_STAGE
#undef PG8_KOFF
#undef PG8_KOFFA
#undef PG8_STAGE_X
#undef PG8_XRD
#undef PG8_LDA
#undef PG8_LDB
#undef PG8_MMA
#undef PG8_WAIT_V
#undef PG8_WAIT_L
#undef PG8_BAR
#undef PG8_SCHED
}
}
#ifndef PG8_SP2
#define PG8_SP2 true
#endif
#ifndef PG8_ALIGN
#define PG8_ALIGN true
#endif
#ifdef PROBE_P1K2
#define P1_ORDER pg8::DupOrder
#elif defined(P1_ROT)
#define P1_ORDER pg8::RotOrder
#elif defined(P1_NF)
#define P1_ORDER pg8::NfOrder
#else
#define P1_ORDER pg8::StaticOrder
#endif
#ifdef P2_REV
#define P2_ORDER pg8::RevOrder
#define P2_PM(pm) (((pm) & ~31) | (31 - ((pm) & 31)))
#else
#define P2_ORDER pg8::StaticOrder
#define P2_PM(pm) (pm)
#endif
namespace attn {
#define ATT_LAS __attribute__((address_space(3)))
typedef unsigned short bf16_t;
typedef short bf16x8 __attribute__((ext_vector_type(8)));
typedef short s16x4 __attribute__((ext_vector_type(4)));
typedef float f32x16 __attribute__((ext_vector_type(16)));
typedef float f32x4 __attribute__((ext_vector_type(4)));
typedef unsigned u32x4 __attribute__((ext_vector_type(4)));
typedef int i32x4 __attribute__((ext_vector_type(4)));
typedef ATT_LAS char* lptr;
constexpr int NW = 8, QBLK = 32, QB = 256, KVBLK = 64, SEQ = 2048;
constexpr int SHM_V = 16384, KROW = 400, SHM_K = 64 * KROW, QRROW = 272, SHM_QR = 32 * QRROW, NQREG = 4;
constexpr int LDS_V = 0, LDS_K = 2 * SHM_V, LDS_QR = LDS_K + 2 * SHM_K, LDS_WS = LDS_QR + NW * SHM_QR, LDS_BYTES = LDS_WS + NW * 256;
constexpr int LDS_MP = LDS_BYTES;
constexpr float THR = 8.f;
#define SBAR() __builtin_amdgcn_sched_barrier(0)
__device__ __forceinline__ int v_st(int k, int c) { const int kk = (k & ~0xC) | ((k & 4) << 1) | ((k & 8) >> 1); return ((kk >> 3) * 4 + (c >> 5)) * 512 + ((kk & 7) * 32 + (c & 31)) * 2; }
__device__ __forceinline__ int v_rd_base(int lane) { return ((lane & 3) << 3) | (((lane >> 2) & 3) << 6) | (((lane >> 4) & 1) << 5) | (((lane >> 5) & 1) << 8); }
constexpr int v_rd_off(int d0, int ks, int half) { return d0 * 512 + ks * 4096 + half * 2048; }
__device__ __forceinline__ int crow(int r, int hi) { return (r & 3) + 8 * (r >> 2) + 4 * hi; }
typedef float f32x2_t __attribute__((ext_vector_type(2))); typedef __bf16 bf16x2_t __attribute__((ext_vector_type(2)));
__device__ __forceinline__ unsigned cvtpk(float lo, float hi) { f32x2_t v = {lo, hi}; bf16x2_t b = __builtin_convertvector(v, bf16x2_t); return __builtin_bit_cast(unsigned, b); }
typedef short v4i16_t __attribute__((ext_vector_type(4)));
__device__ __forceinline__ s16x4 vtr(lptr p) { return __builtin_bit_cast(s16x4, __builtin_amdgcn_ds_read_tr16_b64_v4i16((ATT_LAS v4i16_t*)p)); }

__device__ __forceinline__ void partialSM(f32x16& p0, f32x16& p1, float& m_reg, float& alpha, const float rq  ) {
    float pmax = p0[0];
#pragma unroll
    for (int r = 1; r < 16; ++r) pmax = fmaxf(pmax, p0[r]);
#pragma unroll
    for (int r = 0; r < 16; ++r) pmax = fmaxf(pmax, p1[r]);
    { auto rr = __builtin_amdgcn_permlane32_swap(__float_as_uint(pmax), __float_as_uint(pmax), false, false);
      pmax = fmaxf(__uint_as_float(rr[0]), __uint_as_float(rr[1])) * rq; }
    float mn;
    if (__builtin_expect(__all((pmax - m_reg) <= THR), 1)) { mn = m_reg; alpha = 1.f; }
    else { mn = fmaxf(m_reg, pmax); alpha = __builtin_amdgcn_exp2f(m_reg - mn); m_reg = mn; }
#pragma unroll
    for (int r = 0; r < 16; ++r) { p0[r] = __builtin_fmaf(p0[r], rq, -mn); p1[r] = __builtin_fmaf(p1[r], rq, -mn); }
#pragma unroll
    for (int r = 0; r < 16; ++r) p0[r] = __builtin_amdgcn_exp2f(p0[r]);
}
__device__ __forceinline__ void finishSM(f32x16& p0, f32x16& p1, float alpha, float& l_reg, bf16x8& pa0, bf16x8& pa1, bf16x8& pa2, bf16x8& pa3) {
#pragma unroll
    for (int r = 0; r < 16; ++r) p1[r] = __builtin_amdgcn_exp2f(p1[r]);
    float ps = 0.f;
#pragma unroll
    for (int r = 0; r < 16; ++r) ps += p0[r];
#pragma unroll
    for (int r = 0; r < 16; ++r) ps += p1[r];
    { auto rr = __builtin_amdgcn_permlane32_swap(__float_as_uint(ps), __float_as_uint(ps), false, false);
      ps = __uint_as_float(rr[0]) + __uint_as_float(rr[1]); }
    l_reg = l_reg * alpha + ps;
#define PK4(P, B_, OUT) do { unsigned a0 = cvtpk(P[B_+0], P[B_+1]), a1 = cvtpk(P[B_+2], P[B_+3]);                          \
        unsigned b0 = cvtpk(P[B_+4], P[B_+5]), b1 = cvtpk(P[B_+6], P[B_+7]);                                             \
        auto r0 = __builtin_amdgcn_permlane32_swap(a0, b0, false, false); auto r1 = __builtin_amdgcn_permlane32_swap(a1, b1, false, false); \
        u32x4 w = {r0[0], r1[0], r0[1], r1[1]}; OUT = __builtin_bit_cast(bf16x8, w); } while (0)
    PK4(p0, 0, pa0); PK4(p0, 8, pa1); PK4(p1, 0, pa2); PK4(p1, 8, pa3);
#undef PK4
}
template <int KB>
__device__ __forceinline__ void qkt(f32x16& p0, f32x16& p1, lptr kbase, lptr qrb, const bf16x8* qr) {
    p0 = f32x16{}; p1 = f32x16{};
    lptr a = kbase + KB * SHM_K;
#pragma unroll
    for (int d0 = 0; d0 < 12; ++d0) {
        const bf16x8 b0 = *(const ATT_LAS bf16x8*)(a + d0 * 32);
        const bf16x8 b1 = *(const ATT_LAS bf16x8*)(a + d0 * 32 + 32 * KROW);
        bf16x8 q; if (d0 < NQREG) q = qr[d0]; else q = *(const ATT_LAS bf16x8*)(qrb + (d0 - NQREG) * 32);
        p0 = __builtin_amdgcn_mfma_f32_32x32x16_bf16(b0, q, p0, 0, 0, 0);
        p1 = __builtin_amdgcn_mfma_f32_32x32x16_bf16(b1, q, p1, 0, 0, 0);
    }
}
template <int KB>
__device__ __forceinline__ void qkt_fsm(f32x16& p0, f32x16& p1, lptr kbase, lptr qrb, const bf16x8* qr,
                                        f32x16& y0, f32x16& y1, float alpha, float& l_reg, bf16x8& pa0, bf16x8& pa1, bf16x8& pa2, bf16x8& pa3) {
    p0 = f32x16{}; p1 = f32x16{};
    lptr a = kbase + KB * SHM_K;
    float ps = 0.f;
    bf16x8 kA0, kA1, qA, kB0, kB1, qB, kC0, kC1, qC;
#define QK_LOAD(d0, S) do { k##S##0 = *(const ATT_LAS bf16x8*)(a + (d0) * 32); k##S##1 = *(const ATT_LAS bf16x8*)(a + (d0) * 32 + 32 * KROW); \
        if ((d0) >= NQREG) q##S = *(const ATT_LAS bf16x8*)(qrb + ((d0) - NQREG) * 32); } while (0)
#define QK_MMA(d0, S) do { const bf16x8 q_ = ((d0) < NQREG) ? qr[(d0) < NQREG ? (d0) : 0] : q##S; \
        p0 = __builtin_amdgcn_mfma_f32_32x32x16_bf16(k##S##0, q_, p0, 0, 0, 0); p1 = __builtin_amdgcn_mfma_f32_32x32x16_bf16(k##S##1, q_, p1, 0, 0, 0); } while (0)
#define PK4(P, B_, OUT) do { unsigned a0 = cvtpk(P[B_+0], P[B_+1]), a1 = cvtpk(P[B_+2], P[B_+3]);                          \
        unsigned b0_ = cvtpk(P[B_+4], P[B_+5]), b1_ = cvtpk(P[B_+6], P[B_+7]);                                             \
        auto r0 = __builtin_amdgcn_permlane32_swap(a0, b0_, false, false); auto r1 = __builtin_amdgcn_permlane32_swap(a1, b1_, false, false); \
        u32x4 w = {r0[0], r1[0], r0[1], r1[1]}; OUT = __builtin_bit_cast(bf16x8, w); } while (0)
#define EXP4(B_) do { y1[B_] = __builtin_amdgcn_exp2f(y1[B_]); y1[B_+1] = __builtin_amdgcn_exp2f(y1[B_+1]); y1[B_+2] = __builtin_amdgcn_exp2f(y1[B_+2]); y1[B_+3] = __builtin_amdgcn_exp2f(y1[B_+3]); } while (0)
#define SUM8(P, B_) do { ps += ((P[B_] + P[B_+1]) + (P[B_+2] + P[B_+3])) + ((P[B_+4] + P[B_+5]) + (P[B_+6] + P[B_+7])); } while (0)
    QK_LOAD(0, A); QK_LOAD(1, B); SBAR();
    QK_LOAD(2, C);  QK_MMA(0, A);  EXP4(0);  SBAR();
    QK_LOAD(3, A);  QK_MMA(1, B);  EXP4(4);  SBAR();
    QK_LOAD(4, B);  QK_MMA(2, C);  EXP4(8);  SBAR();
    QK_LOAD(5, C);  QK_MMA(3, A);  EXP4(12); SBAR();
    QK_LOAD(6, A);  QK_MMA(4, B);  SUM8(y0, 0); PK4(y0, 0, pa0); SBAR();
    QK_LOAD(7, B);  QK_MMA(5, C);  SUM8(y0, 8); PK4(y0, 8, pa1); SBAR();
    QK_LOAD(8, C);  QK_MMA(6, A);  SUM8(y1, 0); SBAR();
    QK_LOAD(9, A);  QK_MMA(7, B);  SUM8(y1, 8); SBAR();
    QK_LOAD(10, B); QK_MMA(8, C);  { auto rr = __builtin_amdgcn_permlane32_swap(__float_as_uint(ps), __float_as_uint(ps), false, false); ps = __uint_as_float(rr[0]) + __uint_as_float(rr[1]); l_reg = l_reg * alpha + ps; } SBAR();
    QK_LOAD(11, C); QK_MMA(9, A);  PK4(y1, 0, pa2); SBAR();
    QK_MMA(10, B); PK4(y1, 8, pa3); SBAR();
    QK_MMA(11, C); SBAR();
#undef QK_LOAD
#undef QK_MMA
#undef PK4
#undef EXP4
#undef SUM8
}
template <int VB>
__device__ __forceinline__ void pv_tile(f32x16* o, lptr vb0, bf16x8 pa0, bf16x8 pa1, bf16x8 pa2, bf16x8 pa3) {
#define PV_LD(d0, S) do { lptr b_ = vb0 + VB * SHM_V + v_rd_off(d0, 0, 0); \
        S##l0 = vtr(b_); S##h0 = vtr(b_ + 2048); S##l1 = vtr(b_ + 4096); S##h1 = vtr(b_ + 6144); S##l2 = vtr(b_ + 8192); S##h2 = vtr(b_ + 10240); S##l3 = vtr(b_ + 12288); S##h3 = vtr(b_ + 14336); } while (0)
#define PV_MM(d0, S) do { \
        o[d0] = __builtin_amdgcn_mfma_f32_32x32x16_bf16(pa0, (bf16x8){S##l0[0], S##l0[1], S##l0[2], S##l0[3], S##h0[0], S##h0[1], S##h0[2], S##h0[3]}, o[d0], 0, 0, 0);   \
        o[d0] = __builtin_amdgcn_mfma_f32_32x32x16_bf16(pa1, (bf16x8){S##l1[0], S##l1[1], S##l1[2], S##l1[3], S##h1[0], S##h1[1], S##h1[2], S##h1[3]}, o[d0], 0, 0, 0);   \
        o[d0] = __builtin_amdgcn_mfma_f32_32x32x16_bf16(pa2, (bf16x8){S##l2[0], S##l2[1], S##l2[2], S##l2[3], S##h2[0], S##h2[1], S##h2[2], S##h2[3]}, o[d0], 0, 0, 0);   \
        o[d0] = __builtin_amdgcn_mfma_f32_32x32x16_bf16(pa3, (bf16x8){S##l3[0], S##l3[1], S##l3[2], S##l3[3], S##h3[0], S##h3[1], S##h3[2], S##h3[3]}, o[d0], 0, 0, 0); } while (0)
    s16x4 Al0, Ah0, Al1, Ah1, Al2, Ah2, Al3, Ah3, Bl0, Bh0, Bl1, Bh1, Bl2, Bh2, Bl3, Bh3;
    PV_LD(0, A); SBAR();
    PV_LD(1, B); PV_MM(0, A); SBAR();
    PV_LD(2, A); PV_MM(1, B); SBAR();
    PV_LD(3, B); PV_MM(2, A); SBAR();
    PV_MM(3, B);
#undef PV_LD
#undef PV_MM
}
__device__ __forceinline__ unsigned mul_bf16x2(unsigned a, unsigned g) {
    const float al = __uint_as_float(a << 16), ah = __uint_as_float(a & 0xffff0000u), gl = __uint_as_float(g << 16), gh = __uint_as_float(g & 0xffff0000u);
    return cvtpk(al * gl, ah * gh);
}
__device__ __forceinline__ unsigned mul_silu_bf16x2(unsigned a, unsigned g) {
    const float al = __uint_as_float(a << 16), ah = __uint_as_float(a & 0xffff0000u), gl = __uint_as_float(g << 16), gh = __uint_as_float(g & 0xffff0000u);
    return cvtpk(al * pg8::silu_f(gl), ah * pg8::silu_f(gh));
}
#if defined(FUSE34) && !defined(PROBE_Y_PLAIN)
#define Y_AUX 16
#else
#define Y_AUX NT_AUX
#endif
struct Tensors { const bf16_t *Q, *KN, *KR, *VV, *GA; bf16_t* Y; const float* SSQ; const int *pos, *pmin, *pmax, *hmin; int l2scope; const int* ast; };
typedef __amdgpu_buffer_rsrc_t rsrc_t;
__device__ __forceinline__ rsrc_t mkrsrc(const void* p, unsigned bytes) { return __builtin_amdgcn_make_buffer_rsrc((void*)p, 0, bytes, 0x00020000); }
__device__ __forceinline__ bf16x8 bload(rsrc_t r, int voff, int soff) { return __builtin_bit_cast(bf16x8, __builtin_amdgcn_raw_buffer_load_b128(r, voff, soff, 0)); }
__device__ __forceinline__ void mask_tile_pos(f32x16& p0, f32x16& p1, int pq, rsrc_t rP, int pvo, int pso) {
    const float NEG = -__builtin_inff();
#pragma unroll
    for (int g = 0; g < 4; ++g) { const i32x4 a = __builtin_bit_cast(i32x4, __builtin_amdgcn_raw_buffer_load_b128(rP, pvo + 32 * g, pso, 0)), b = __builtin_bit_cast(i32x4, __builtin_amdgcn_raw_buffer_load_b128(rP, pvo + 128 + 32 * g, pso, 0));
#pragma unroll
        for (int i = 0; i < 4; ++i) { if (pq < a[i]) p0[4 * g + i] = NEG; if (pq < b[i]) p1[4 * g + i] = NEG; }
        asm volatile("" ::: "memory"); }
}
__device__ __forceinline__ void mask_tile_lds(f32x16& p0, f32x16& p1, int pq, lptr mp, int hi) {
    const float NEG = -__builtin_inff();
#pragma unroll
    for (int g = 0; g < 4; ++g) { const i32x4 a = *(const ATT_LAS i32x4*)(mp + (8 * g + 4 * hi) * 4), b = *(const ATT_LAS i32x4*)(mp + (32 + 8 * g + 4 * hi) * 4);
#pragma unroll
        for (int i = 0; i < 4; ++i) { if (pq < a[i]) p0[4 * g + i] = NEG; if (pq < b[i]) p1[4 * g + i] = NEG; } }
}
__device__ __forceinline__ void attn_unit(int b, int h, int qb, const Tensors& T, lptr lds) {
    int tid = threadIdx.x; asm volatile("" : "+v"(tid));
    const int wid = __builtin_amdgcn_readfirstlane(tid >> 6), lane = tid & 63, r32 = lane & 31, hi = lane >> 5;
    const int rowbase = b * SEQ, q0 = qb * QB;
    constexpr unsigned MTOK = 65536u;
    const rsrc_t rQ = mkrsrc(T.Q, MTOK * 768u * 2u), rKN = mkrsrc(T.KN, MTOK * 512u * 2u), rKR = mkrsrc(T.KR, MTOK * 64u * 2u), rVV = mkrsrc(T.VV, MTOK * 512u * 2u),
                 rGA = mkrsrc(T.GA, MTOK * 512u * 2u), rY = mkrsrc(T.Y, MTOK * 1024u * 2u), rYS = mkrsrc((const char*)T.Y + (668u << 20), MTOK * 1024u * 2u), rP = mkrsrc(T.pos, MTOK * 4u);
    lptr V_lds = lds + LDS_V; lptr K_lds = lds + LDS_K; lptr QRw = lds + LDS_QR + wid * SHM_QR;
    ATT_LAS float* ws = (ATT_LAS float*)(lds + LDS_WS) + wid * 64; ATT_LAS float* li_l = ws; ATT_LAS float* al_l = ws + 32;
#if TILE_KV
    const int sr = 16 * ((tid >> 8) & 1) + ((tid & 63) >> 2), sc = 4 * ((tid >> 6) & 3) + (tid & 3), rr = tid >> 3, rc = tid & 7;
#else
    const int sr = tid >> 4, sc = tid & 15, rr = tid >> 3, rc = tid & 7;
#endif
    const int kw0 = sr * KROW + sc * 16, kw2 = rr * KROW + 256 + rc * 16;
    const int vst0 = v_st(sr, sc * 8); constexpr int vst1d = 8192;
#if TILE_KV
    const int kv_vo = tid * 16, kr_vo = (rr * 64 + rc * 8) * 2;
    const int kv_s0 = ((rowbase >> 11) * 4 + h) * 524288, kr_s0 = rowbase * 64 * 2;
#define KV_TSTRIDE 16384
#define KV_HALF 8192
#else
    const int kv_vo = (sr * 512 + sc * 8) * 2, kr_vo = (rr * 64 + rc * 8) * 2;
    const int kv_s0 = (rowbase * 512 + h * 128) * 2, kr_s0 = rowbase * 64 * 2;
#define KV_TSTRIDE 65536
#define KV_HALF 32768
#endif
    bf16x8 st_k0, st_k1, st_k2, st_v0, st_v1;
#define VMW() asm volatile("s_waitcnt vmcnt(0)" ::: "memory")
#define SLOAD(t) do { const int so_ = kv_s0 + (t) * KV_TSTRIDE; st_v0 = bload(rVV, kv_vo, so_); st_v1 = bload(rVV, kv_vo, so_ + KV_HALF); \
        st_k0 = bload(rKN, kv_vo, so_); st_k1 = bload(rKN, kv_vo, so_ + KV_HALF); st_k2 = bload(rKR, kr_vo, kr_s0 + (t) * 8192); } while (0)
#define SWRITE(bf) do { *(ATT_LAS bf16x8*)(V_lds + (bf) * SHM_V + vst0) = st_v0; *(ATT_LAS bf16x8*)(V_lds + (bf) * SHM_V + vst0 + vst1d) = st_v1; \
        *(ATT_LAS bf16x8*)(K_lds + (bf) * SHM_K + kw0) = st_k0; *(ATT_LAS bf16x8*)(K_lds + (bf) * SHM_K + kw0 + 32 * KROW) = st_k1; *(ATT_LAS bf16x8*)(K_lds + (bf) * SHM_K + kw2) = st_k2; } while (0)
    SLOAD(0);
    bf16x8 qr[NQREG], qtmp[8]; int qw_off;
#if TILE_Q
    { const int q_s0 = (((rowbase >> 11) * 4 + h) * 128 + ((q0 + wid * QBLK) >> 4)) * 6144;
      int lp = lane; asm volatile("" : "+v"(lp));
      const int qf_vo = ((lp & 31) >> 4) * 6144 + (lp & 15) * 64 + (lp >> 5) * 16;
#pragma unroll
      for (int d0 = 0; d0 < NQREG; ++d0) qr[d0] = bload(rQ, qf_vo + (d0 >> 1) * 1024 + (d0 & 1) * 32, q_s0);
      const int row = lp >> 1, c0 = (lp & 1) * 8; const int qc_vo = (row >> 4) * 6144 + (row & 15) * 64 + (2 + 2 * (lp & 1)) * 1024;
#pragma unroll
      for (int j = 0; j < 8; ++j) qtmp[j] = bload(rQ, qc_vo + (j >> 2) * 1024 + (j & 3) * 16, q_s0);
#else
    { const int q_s0 = ((rowbase + q0 + wid * QBLK) * 768 + h * 192) * 2;
      int lp = lane; asm volatile("" : "+v"(lp));
      const int qf_vo = ((lp & 31) * 768 + (lp >> 5) * 8) * 2;
#pragma unroll
      for (int d0 = 0; d0 < NQREG; ++d0) qr[d0] = bload(rQ, qf_vo + d0 * 32, q_s0);
      const int row = lp >> 1, c0 = (lp & 1) * 8; const int qc_vo = (row * 768 + 64 + c0 * 8) * 2;
#pragma unroll
      for (int j = 0; j < 8; ++j) qtmp[j] = bload(rQ, qc_vo + j * 16, q_s0);
#endif
      qw_off = row * QRROW + c0 * 16; }
    const int tb = qb * 4 < 28 ? qb * 4 : 28;
    const int pq_u = __builtin_amdgcn_raw_buffer_load_b32(rP, r32 * 4, (rowbase + q0 + wid * QBLK) * 4, 0);
    int mp_v = 0; if (tid < 256) mp_v = __builtin_amdgcn_raw_buffer_load_b32(rP, tid * 4, (rowbase + tb * KVBLK) * 4, 0);
#ifdef ATT_PRESTATS
    const int* asp = T.ast + ((b * 8 + qb) * 8 + wid) * 2;
    const int NT = __builtin_amdgcn_readfirstlane(asp[0]);
    const unsigned mbits = (unsigned)__builtin_amdgcn_readfirstlane(asp[1]);
#else
    int NT;
    { const int* pmx = T.pmax + b * 32 + 4 * qb; const int qmax = max(max(pmx[0], pmx[1]), max(pmx[2], pmx[3]));
      const int pml = T.pmin[b * 32 + (lane & 31)];
      const unsigned m32 = (unsigned)__ballot(pml <= qmax);
      NT = m32 ? 32 - __clz(m32) : 1; NT = __builtin_amdgcn_readfirstlane(NT); }
    const int qminw = __builtin_amdgcn_readfirstlane(T.hmin[b * 64 + qb * 8 + wid]);
    const unsigned mbits = (unsigned)__builtin_amdgcn_readfirstlane((int)(unsigned)__ballot(T.pmax[b * 32 + (lane & 31)] > qminw));
#endif
    float rq;
    { const f32x4* sp = (const f32x4*)(T.SSQ + (size_t)(rowbase + q0 + wid * QBLK + r32) * 8); const f32x4 s0 = sp[0], s1 = sp[1];
      rq = __builtin_amdgcn_rsqf((((s0[0] + s0[1]) + (s0[2] + s0[3])) + ((s1[0] + s1[1]) + (s1[2] + s1[3]))) * (1.0f / 512.0f) + 1e-6f) * (0.07216878364870323f * 1.4426950408889634f); }
#pragma unroll
    for (int j = 0; j < 8; ++j) *(ATT_LAS bf16x8*)(QRw + qw_off + j * 16) = qtmp[j];
    if (tid < 256) *(ATT_LAS int*)(lds + LDS_MP + tid * 4) = mp_v;
    lptr qrb = QRw + r32 * QRROW + hi * 16;
    lptr kbase = K_lds + r32 * KROW + hi * 16;
    lptr vb0 = V_lds + v_rd_base(lane);
    float m_reg = -1e30f, l_reg = 0.f; f32x16 o[4] = {};
#define RESC(a) do { if (__any((a) < 1.f)) { if (hi == 0) al_l[r32] = (a); asm volatile("s_waitcnt lgkmcnt(0)" ::: "memory");              \
                     _Pragma("unroll") for (int d_ = 0; d_ < 4; ++d_) _Pragma("unroll") for (int r = 0; r < 16; ++r) o[d_][r] *= al_l[crow(r, hi)]; } } while (0)
#ifdef ATT_MPLDS
#define MASKT(P0_, P1_, t) do { if ((mbits >> (t)) & 1u) { if ((t) >= tb && (t) < tb + 4) mask_tile_lds(P0_, P1_, pq_u, lds + LDS_MP + ((t) - tb) * 256, hi); \
        else mask_tile_pos(P0_, P1_, pq_u, rP, hi * 16, (rowbase + (t) * KVBLK) * 4); } } while (0)
#else
#define MASKT(P0_, P1_, t) do { if ((mbits >> (t)) & 1u) mask_tile_pos(P0_, P1_, __builtin_amdgcn_raw_buffer_load_b32(rP, r32 * 4, (rowbase + q0 + wid * QBLK) * 4, 0), rP, hi * 16, (rowbase + (t) * KVBLK) * 4); } while (0)
#endif
    f32x16 pA0, pA1, pB0, pB1; float alA, alB; bf16x8 pa0, pa1, pa2, pa3;
    VMW(); SWRITE(0);
    if (NT > 1) SLOAD(1);
    __syncthreads();
    SBAR(); qkt<0>(pA0, pA1, kbase, qrb, qr);
    MASKT(pA0, pA1, 0); partialSM(pA0, pA1, m_reg, alA, rq);
    if (NT > 1) { VMW(); SWRITE(1); }
    __syncthreads();
#define HALF_STEP(PX0, PX1, alX, PY0, PY1, alY, t, KB, VB, SB) do {                                                      \
        SBAR(); if ((t) + 1 < NT) { SLOAD((t) + 1); SBAR(); }     \
        qkt_fsm<KB>(PX0, PX1, kbase, qrb, qr, PY0, PY1, alY, l_reg, pa0, pa1, pa2, pa3); SBAR();                          \
        pv_tile<VB>(o, vb0, pa0, pa1, pa2, pa3); MASKT(PX0, PX1, (t)); partialSM(PX0, PX1, m_reg, alX, rq);                   \
        __syncthreads();                                                                                                  \
        if ((t) + 1 < NT) { VMW(); SWRITE(SB); }                                                                          \
        RESC(alX); __syncthreads(); } while (0)
    for (int t = 1; t + 1 < NT; t += 2) {
        HALF_STEP(pB0, pB1, alB, pA0, pA1, alA, t, 1, 0, 0);
        HALF_STEP(pA0, pA1, alA, pB0, pB1, alB, t + 1, 0, 1, 1);
    }
    const bool even = (NT & 1) == 0;
    if (even) { SBAR(); qkt<1>(pB0, pB1, kbase, qrb, qr); SBAR(); }
    finishSM(pA0, pA1, alA, l_reg, pa0, pa1, pa2, pa3); SBAR();
    pv_tile<0>(o, vb0, pa0, pa1, pa2, pa3);
    if (even) { MASKT(pB0, pB1, NT - 1); partialSM(pB0, pB1, m_reg, alB, rq); RESC(alB);
        finishSM(pB0, pB1, alB, l_reg, pa0, pa1, pa2, pa3); SBAR(); pv_tile<1>(o, vb0, pa0, pa1, pa2, pa3); }
#ifdef ATT_GPF
    u32x4 gpf[8];
    { int le = lane; asm volatile("" : "+v"(le)); const int tok0 = rowbase + q0 + wid * QBLK;
#ifdef TILE_Y
#pragma unroll
      for (int i = 0; i < 8; ++i) gpf[i] = __builtin_amdgcn_raw_buffer_load_b128(rGA, le * 16, ((tok0 >> 4) + (i >> 2)) * 16384 + (4 * h + (i & 3)) * 1024, 0); }
#elif TILE_GATES
      const int g_vo = (le >> 4) * 64 + ((le & 15) >> 2) * 1024 + (le & 3) * 16;
#pragma unroll
      for (int i = 0; i < 8; ++i) gpf[i] = __builtin_amdgcn_raw_buffer_load_b128(rGA, g_vo, ((tok0 >> 4) + (i >> 2)) * 16384 + ((4 * i) & 15) * 64 + h * 4096, 0); }
#else
      const int g_vo = ((le >> 4) * 512 + (le & 15) * 8) * 2;
#pragma unroll
      for (int i = 0; i < 8; ++i) gpf[i] = __builtin_amdgcn_raw_buffer_load_b128(rGA, g_vo, ((tok0 + i * 4) * 512 + h * 128) * 2, 0); }
#endif
#endif
    if (hi == 0) li_l[r32] = l_reg; asm volatile("s_waitcnt lgkmcnt(0)" ::: "memory");
    float rli[16];
#pragma unroll
    for (int r = 0; r < 16; ++r) rli[r] = __builtin_amdgcn_rcpf(li_l[crow(r, hi)]);
    __syncthreads();
#ifdef TILE_Y
    constexpr int OP = 320;
    lptr stg = lds + wid * (32 * OP);
#pragma unroll
    for (int r = 0; r < 16; ++r) { const int orow = crow(r, hi);
#pragma unroll
        for (int d0 = 0; d0 < 4; ++d0) *(ATT_LAS unsigned short*)(stg + orow * OP + (d0 * 32 + r32) * 2) = (unsigned short)(cvtpk(o[d0][r] * rli[r], 0.f) & 0xffffu); }
    asm volatile("s_waitcnt lgkmcnt(0)" ::: "memory");
    { int le = lane; asm volatile("" : "+v"(le)); const int tok0 = rowbase + q0 + wid * QBLK; const int s_rd = (le >> 2) * OP + (le & 3) * 16;
#pragma unroll
      for (int i = 0; i < 8; ++i) {
        const u32x4 ov = *(const ATT_LAS u32x4*)(stg + s_rd + (i >> 2) * 16 * OP + (i & 3) * 64);
        const u32x4 gv = gpf[i];
        u32x4 y; y.x = mul_bf16x2(ov.x, gv.x); y.y = mul_bf16x2(ov.y, gv.y); y.z = mul_bf16x2(ov.z, gv.z); y.w = mul_bf16x2(ov.w, gv.w);
#ifdef Y_L2SCOPE
        if (T.l2scope) __builtin_amdgcn_raw_buffer_store_b128(y, rY, le * 16 + ((tok0 >> 4) + (i >> 2)) * 32768 + (4 * h + (i & 3)) * 1024, 0, 0); else
#endif
        __builtin_amdgcn_raw_buffer_store_b128(y, rY, le * 16 + ((tok0 >> 4) + (i >> 2)) * 32768 + (4 * h + (i & 3)) * 1024, 0, Y_AUX); } }
#if defined(FUSE34) && !defined(FUSE34_KROT)
    asm volatile("s_waitcnt vmcnt(0)" ::: "memory");
#endif
#else
    lptr stg = lds + wid * 8192;
#pragma unroll
    for (int r = 0; r < 16; ++r) { const int orow = crow(r, hi);
#pragma unroll
        for (int d0 = 0; d0 < 4; ++d0) *(ATT_LAS unsigned short*)(stg + orow * 256 + (d0 * 32 + r32) * 2) = (unsigned short)(cvtpk(o[d0][r] * rli[r], 0.f) & 0xffffu); }
    asm volatile("s_waitcnt lgkmcnt(0)" ::: "memory");
    { int le = lane; asm volatile("" : "+v"(le)); const int rowl = le >> 4, ch = le & 15; const int g_vo = (rowl * 512 + ch * 8) * 2, y_vo = (rowl * 1024 + ch * 8) * 2;
      const int tok0 = rowbase + q0 + wid * QBLK;
#pragma unroll
      for (int i = 0; i < 8; ++i) {
        const u32x4 ov = *(const ATT_LAS u32x4*)(stg + (i * 4 + rowl) * 256 + ch * 16);
#ifdef ATT_GPF
        const u32x4 gv = gpf[i];
#else
        const u32x4 gv = __builtin_amdgcn_raw_buffer_load_b128(rGA, g_vo, ((tok0 + i * 4) * 512 + h * 128) * 2, 0);
#endif
        u32x4 y;
#if GA_SILU_IN_ATTN
        y.x = mul_silu_bf16x2(ov.x, gv.x); y.y = mul_silu_bf16x2(ov.y, gv.y); y.z = mul_silu_bf16x2(ov.z, gv.z); y.w = mul_silu_bf16x2(ov.w, gv.w);
#else
        y.x = mul_bf16x2(ov.x, gv.x); y.y = mul_bf16x2(ov.y, gv.y); y.z = mul_bf16x2(ov.z, gv.z); y.w = mul_bf16x2(ov.w, gv.w);
#endif
#ifdef Y_L2SCOPE
        if (T.l2scope) __builtin_amdgcn_raw_buffer_store_b128(y, rY, y_vo + ((tok0 + i * 4) * 1024 + h * 128) * 2, 0, 0);
        else
#endif
        __builtin_amdgcn_raw_buffer_store_b128(y, rY, y_vo + ((tok0 + i * 4) * 1024 + h * 128) * 2, 0, Y_AUX);
#ifdef PROBE_YST_A
        __builtin_amdgcn_raw_buffer_store_b128(y, rYS, y_vo + ((tok0 + i * 4) * 1024 + h * 128) * 2, 0, Y_AUX);
#endif
#ifdef PROBE_YST_B
        __builtin_amdgcn_raw_buffer_store_b128(y, rYS, le * 16 + ((tok0 + i * 4) * 1024 + h * 128) * 2, 0, Y_AUX);
#endif
        } }
#if defined(FUSE34) && !defined(FUSE34_KROT)
    asm volatile("s_waitcnt vmcnt(0)" ::: "memory");
#endif
#endif
    __syncthreads();
#undef RESC
#undef MASKT
#undef HALF_STEP
#undef SLOAD
#undef SWRITE
#undef VMW
}
#undef SBAR
}
namespace pool {
#define POOL_LAS __attribute__((address_space(3)))
typedef unsigned short bf16_t;
typedef short bf16x8 __attribute__((ext_vector_type(8)));
typedef float f32x16 __attribute__((ext_vector_type(16)));
typedef unsigned u32x4 __attribute__((ext_vector_type(4)));
typedef unsigned u32x2 __attribute__((ext_vector_type(2)));
typedef POOL_LAS char* lptr;
constexpr int ROWB = 272;
constexpr int LDS_A = 0, LDS_W = 256 * ROWB, LDS_BYTES = LDS_W + 128 * ROWB;
typedef float f32x2_t __attribute__((ext_vector_type(2))); typedef __bf16 bf16x2_t __attribute__((ext_vector_type(2)));
__device__ __forceinline__ unsigned cvtpk(float lo, float hi) { f32x2_t v = {lo, hi}; bf16x2_t b = __builtin_convertvector(v, bf16x2_t); return __builtin_bit_cast(unsigned, b); }
__device__ __forceinline__ void unpack8(const u32x4 v, float (&f)[8]) {
    f[0] = __uint_as_float(v.x << 16); f[1] = __uint_as_float(v.x & 0xffff0000u); f[2] = __uint_as_float(v.y << 16); f[3] = __uint_as_float(v.y & 0xffff0000u);
    f[4] = __uint_as_float(v.z << 16); f[5] = __uint_as_float(v.z & 0xffff0000u); f[6] = __uint_as_float(v.w << 16); f[7] = __uint_as_float(v.w & 0xffff0000u);
}
template <int W, bool EDGE>
#if TILE_U
#define POOL_UROW(jj) ((const u32x4*)((const char*)Ug + (size_t)((tok + (jj)) >> 4) * 16384 + (size_t)((tok + (jj)) & 15) * 64))
#else
#define POOL_UROW(jj) ((const u32x4*)(Ug + (ptrdiff_t)(jj) * 512))
#endif
__device__ __forceinline__ void pool_rows(const bf16_t* Ug  , int s0, lptr dst  , int tok) {
    u32x4 rv[W + 7];
#pragma unroll
    for (int j = 0; j < W + 7; ++j) { const int jj = j - (W - 1); const bool ok = (s0 + jj) >= 0;
        if constexpr (EDGE) { const u32x4 v = *POOL_UROW(ok ? jj : 0); rv[j] = ok ? v : (u32x4){0u, 0u, 0u, 0u}; }
        else rv[j] = *POOL_UROW(jj); }
    float S[8];
#pragma unroll
    for (int c = 0; c < 8; ++c) S[c] = 0.f;
#pragma unroll
    for (int j = 0; j < W - 1; ++j) { float f[8]; unpack8(rv[j], f);
#pragma unroll
        for (int c = 0; c < 8; ++c) S[c] += f[c]; }
#pragma unroll
    for (int i = 0; i < 8; ++i) { float f[8]; unpack8(rv[i + W - 1], f);
#pragma unroll
        for (int c = 0; c < 8; ++c) S[c] += f[c];
        const int cnt = (s0 + i + 1) < W ? (s0 + i + 1) : W; const float ic = 1.0f / (float)cnt;
        u32x4 o; o.x = cvtpk(S[0] * ic - f[0], S[1] * ic - f[1]); o.y = cvtpk(S[2] * ic - f[2], S[3] * ic - f[3]); o.z = cvtpk(S[4] * ic - f[4], S[5] * ic - f[5]); o.w = cvtpk(S[6] * ic - f[6], S[7] * ic - f[7]);
        *(POOL_LAS u32x4*)(dst + i * ROWB) = o;
        float g[8]; unpack8(rv[i], g);
#pragma unroll
        for (int c = 0; c < 8; ++c) S[c] -= g[c]; }
}
struct Tensors { const bf16_t *U, *GB, *PWT; bf16_t* Y; };
__device__ __forceinline__ void pool_unit(int pm, int g, const Tensors& T, lptr lds, int npm = -1, int ng = 0) {
    int tid = threadIdx.x; asm volatile("" : "+v"(tid));
    const int wid = __builtin_amdgcn_readfirstlane(tid >> 6), lane = tid & 63, r32 = lane & 31, hi = lane >> 5;
    __syncthreads();
#ifdef POOL_GPF
    u32x4 gpf[8];
#pragma unroll
#ifdef TILE_Y
    for (int i = 0; i < 8; ++i) gpf[i] = *(const u32x4*)((const char*)T.GB + ((size_t)(pm * 16 + wid * 2 + (i >> 2)) * 16 + (size_t)(4 * g + (i & 3))) * 1024 + lane * 16);
#else
    for (int i = 0; i < 8; ++i) { const int row = i * 4 + (lane >> 4), ch = lane & 15; const size_t tok = (size_t)pm * 256 + wid * 32 + row;
#if TILE_GATES
        gpf[i] = *(const u32x4*)((const char*)T.GB + pg8::t512(tok, g * 128 + ch * 8)); }
#else
        gpf[i] = *(const u32x4*)(T.GB + tok * 512 + g * 128 + ch * 8); }
#endif
#endif

#endif
#ifdef POOL_GPF
    u32x4 wpf[4];
    { const bf16_t* w = T.PWT + (size_t)g * 128 * 128;
#pragma unroll
      for (int i = 0; i < 4; ++i) { const int id = tid + 512 * i, n = id >> 4, ch = id & 15; wpf[i] = *(const u32x4*)(w + n * 128 + ch * 8); } }
#else
    { const bf16_t* w = T.PWT + (size_t)g * 128 * 128;
#pragma unroll
      for (int i = 0; i < 4; ++i) { const int id = tid + 512 * i, n = id >> 4, ch = id & 15; *(POOL_LAS u32x4*)(lds + LDS_W + n * ROWB + ch * 16) = *(const u32x4*)(w + n * 128 + ch * 8); } }
#endif
    { const int ch = tid & 15, rg = tid >> 4; const size_t tok = (size_t)pm * 256 + rg * 8; const int s0 = (int)(tok & 2047);
#if TILE_U
      const bf16_t* Ug = (const bf16_t*)((const char*)T.U + (size_t)(g * 4 + (ch >> 2)) * 1024 + (ch & 3) * 16); lptr dst = lds + LDS_A + rg * 8 * ROWB + ch * 16;
#else
      const bf16_t* Ug = T.U + tok * 512 + g * 128 + ch * 8; lptr dst = lds + LDS_A + rg * 8 * ROWB + ch * 16;
#endif
      if ((pm & 7) == 0) { if (g == 0) pool_rows<2, true>(Ug, s0, dst, (int)tok); else if (g == 1) pool_rows<4, true>(Ug, s0, dst, (int)tok); else if (g == 2) pool_rows<8, true>(Ug, s0, dst, (int)tok); else pool_rows<16, true>(Ug, s0, dst, (int)tok); }
      else { if (g == 0) pool_rows<2, false>(Ug, s0, dst, (int)tok); else if (g == 1) pool_rows<4, false>(Ug, s0, dst, (int)tok); else if (g == 2) pool_rows<8, false>(Ug, s0, dst, (int)tok); else pool_rows<16, false>(Ug, s0, dst, (int)tok); } }
#ifdef POOL_GPF
#pragma unroll
    for (int i = 0; i < 4; ++i) { const int id = tid + 512 * i, n = id >> 4, ch = id & 15; *(POOL_LAS u32x4*)(lds + LDS_W + n * ROWB + ch * 16) = wpf[i]; }
#endif
#ifdef POOL_TOUCH
    unsigned tch0 = 0u, tch1 = 0u;
    if (npm >= 0) { const size_t nt_ = (size_t)npm * 256 + (tid >> 1); const int co = ng * 128 + (tid & 1) * 64;
        tch0 = *(const unsigned*)(T.U + nt_ * 512 + co); tch1 = *(const unsigned*)(T.GB + nt_ * 512 + co); }
#endif
    __syncthreads();
    f32x16 acc[4] = {};
    lptr ab = lds + LDS_W + r32 * ROWB + hi * 16, bb = lds + LDS_A + (wid * 32 + r32) * ROWB + hi * 16;
#pragma unroll
    for (int ks = 0; ks < 8; ++ks) { const bf16x8 bq = *(const POOL_LAS bf16x8*)(bb + ks * 32);
#pragma unroll
        for (int nt = 0; nt < 4; ++nt) { const bf16x8 aw = *(const POOL_LAS bf16x8*)(ab + nt * 32 * ROWB + ks * 32);
            acc[nt] = __builtin_amdgcn_mfma_f32_32x32x16_bf16(aw, bq, acc[nt], 0, 0, 0); } }
    lptr stg = lds + LDS_A + wid * 32 * ROWB;
#pragma unroll
    for (int nt = 0; nt < 4; ++nt)
#pragma unroll
        for (int rq = 0; rq < 4; ++rq) { u32x2 w; w.x = cvtpk(acc[nt][4 * rq], acc[nt][4 * rq + 1]); w.y = cvtpk(acc[nt][4 * rq + 2], acc[nt][4 * rq + 3]);
            *(POOL_LAS u32x2*)(stg + r32 * ROWB + (32 * nt + 8 * rq + 4 * hi) * 2) = w; }
    asm volatile("s_waitcnt lgkmcnt(0)" ::: "memory");
#ifdef TILE_Y
#pragma unroll
    for (int i = 0; i < 8; ++i) { const u32x4 ov = *(const POOL_LAS u32x4*)(stg + ((i >> 2) * 16 + (lane >> 2)) * ROWB + (i & 3) * 64 + (lane & 3) * 16); const u32x4 gv = gpf[i];
        float of[8], gf[8]; unpack8(ov, of); unpack8(gv, gf);
#pragma unroll
        for (int c = 0; c < 8; ++c) of[c] *= pg8::silu_f(gf[c]);
        u32x4 y; y.x = cvtpk(of[0], of[1]); y.y = cvtpk(of[2], of[3]); y.z = cvtpk(of[4], of[5]); y.w = cvtpk(of[6], of[7]);
        PLST((char*)T.Y + ((size_t)(pm * 16 + wid * 2 + (i >> 2)) * 32 + (size_t)(16 + 4 * g + (i & 3))) * 1024 + lane * 16, y); }
#else
#pragma unroll
    for (int i = 0; i < 8; ++i) { const int row = i * 4 + (lane >> 4), ch = lane & 15; const size_t tok = (size_t)pm * 256 + wid * 32 + row;
        const u32x4 ov = *(const POOL_LAS u32x4*)(stg + row * ROWB + ch * 16);
#ifdef POOL_GPF
        const u32x4 gv = gpf[i];
#else
        const u32x4 gv = RDP_NT ? __builtin_nontemporal_load((const u32x4*)(T.GB + tok * 512 + g * 128 + ch * 8)) : *(const u32x4*)(T.GB + tok * 512 + g * 128 + ch * 8);
#endif
        u32x4 y;
#if GB_SILU_IN_POOL
        { float of[8], gf[8]; unpack8(ov, of); unpack8(gv, gf);
#pragma unroll
          for (int c = 0; c < 8; ++c) of[c] *= pg8::silu_f(gf[c]);
          y.x = cvtpk(of[0], of[1]); y.y = cvtpk(of[2], of[3]); y.z = cvtpk(of[4], of[5]); y.w = cvtpk(of[6], of[7]); }
#else
        y.x = attn::mul_bf16x2(ov.x, gv.x); y.y = attn::mul_bf16x2(ov.y, gv.y); y.z = attn::mul_bf16x2(ov.z, gv.z); y.w = attn::mul_bf16x2(ov.w, gv.w);
#endif
#ifdef FUSE34_POOL
        __builtin_amdgcn_raw_buffer_store_b128(y, __builtin_amdgcn_make_buffer_rsrc((void*)T.Y, 0, 65536u * 1024u * 2u, 0x00020000), (int)((tok * 1024 + 512 + g * 128 + ch * 8) * 2), 0, 16); }
#else
        NTST(T.Y + tok * 1024 + 512 + g * 128 + ch * 8, y); }
#endif
#endif
#ifdef POOL_TOUCH
    asm volatile("" :: "v"(tch0), "v"(tch1));
#endif
}
}
constexpr int NWAVES = 8;
#ifndef MK_N_LAUNCHES
#define MK_N_LAUNCHES 1
#endif
constexpr int N_LAUNCHES = MK_N_LAUNCHES;
constexpr int PER_PHASE = 5;

constexpr int BATCH = 32, SEQ = 2048, D = 1024, M = BATCH * SEQ;
#if defined(ROPE_P0) && !defined(PROBE_ROPE_BOTH)
constexpr int NIN = 2304;
#else
constexpr int NIN = 2560;
#endif
constexpr float LN_EPS = 1e-5f;
constexpr float ALPHA = 1.189207115002721f;

constexpr size_t MiB = 1u << 20;
constexpr size_t WS_CTL = 0, CTL_ZERO_BYTES = 1 * MiB;
constexpr size_t WS_WIN = 2 * MiB, WS_WUQ = 7 * MiB, WS_WUKV = 8 * MiB, WS_PW = 8 * MiB + 512 * 1024, WS_WOUT = 9 * MiB;
constexpr size_t WS_POSMM = 11 * MiB;
constexpr size_t WS_XCH = 12 * MiB, WS_SSQ = 14 * MiB, WS_SSKV = 16 * MiB;
constexpr size_t WS_KR = 24 * MiB, WS_XB = 32 * MiB, WS_Y = 32 * MiB  , WS_XQ = 160 * MiB, WS_XKV = 224 * MiB;
constexpr size_t WS_GA = 256 * MiB, WS_U = 320 * MiB, WS_GB = 384 * MiB, WS_Q = 448 * MiB, WS_KN = 544 * MiB, WS_VV = 608 * MiB, WS_STAT = 672 * MiB  , WS_END = 680 * MiB;
constexpr int CW_TMO = 0, CW_CODE = 1;
constexpr int CW_BAR = 4096;
constexpr int CW_SEAM = 32768;
constexpr int CW_XCC = 12288;
constexpr int CW_LBAR = 16384;
constexpr int CW_PANEL = 131072;
static_assert((CW_SEAM + 4 * 256 * 64) * 4 <= (int)CTL_ZERO_BYTES, "CTL words inside the memset region");

constexpr int RING_OFF = 0, RING_BYTES = 157696;
constexpr int LDSCTL_OFF = RING_BYTES, MISC_OFF = LDSCTL_OFF + 320;
constexpr int RSTAT_OFF = pg8::LN_TAB_OFF;
constexpr int LDS_BYTES = 158208;
static_assert(MISC_OFF + 128 <= LDS_BYTES && attn::LDS_BYTES <= RING_BYTES && pool::LDS_BYTES <= RING_BYTES, "LDS map");

struct Frame {
    LAS unsigned char* lds;
    volatile LAS unsigned* MISC;
    gu32* ctl;
    int tid, lane, wave;
    int vcu, G;
};

__device__ __forceinline__ int rope_orig(int p) { return 16 * (p >> 5) + 4 * ((p >> 3) & 3) + (p & 3) + 32 * ((p >> 2) & 1); }
struct Args { const void* in[12]; float* out; unsigned char* ws; int ph_lo, ph_hi, li, pad; };

#ifdef P0_PLAIN_LD
#define P0_LD(p) (*(p))
#else
#define P0_LD(p) __builtin_nontemporal_load(p)
#endif
#ifdef TILE_Y
#define TILE_Y_FLAG 1
#else
#define TILE_Y_FLAG 0
#endif
#ifdef TILE_XB
#define TILE_XB_FLAG 1
#else
#define TILE_XB_FLAG 0
#endif

#ifdef ROPE_P0
typedef float f32x16_p0 __attribute__((ext_vector_type(16)));
struct P0False { static constexpr bool value = false; }; struct P0True { static constexpr bool value = true; };
constexpr int P0_SP = 272, P0_WAVE = 32 * P0_SP, P0_PART = 8 * P0_WAVE;
static_assert(2 * P0_PART <= RING_BYTES, "prologue LDS");
#ifdef TILE_XB
#define P0_ROW(i) (16 * ((i) >> 2) + (l >> 2))
#define P0_COL(i) (32 * ((i) & 3) + 8 * (l & 3))
#define P0_XB(R, i) ((bf16*)((char*)xb + ((((R) >> 4) + ((i) >> 2)) * 32 + (size_t)(4 * w + ((i) & 3))) * 1024 + (size_t)l * 16))
#else
#define P0_ROW(i) (4 * (i) + lr)
#define P0_COL(i) (lc * 8)
#define P0_XB(R, i) (xb + ((R) + P0_ROW(i)) * 1024 + 128 * w + P0_COL(i))
#endif
#define P0_XLOADS(R) do { _Pragma("unroll") for (int i = 0; i < 8; ++i) { const float* xp_ = x + ((R) + P0_ROW(i)) * 1024 + 128 * w + P0_COL(i); cur[2 * i] = P0_LD((const f32x4*)xp_); cur[2 * i + 1] = P0_LD((const f32x4*)(xp_ + 4)); } } while (0)
template <class Mid>
__device__ __forceinline__ void p0_x_rope(const Frame& F, const float* x, const float* w_in, const int* pos, bf16* xb, bf16* KR, Mid&& mid) {
    const int w = F.wave, l = F.lane, r32 = l & 31, hi = l >> 5, lr = l >> 4, lc = l & 15;
    f32x4 cur[16];
    if (F.vcu < M / 32) P0_XLOADS((size_t)F.vcu * 32);
    bf16x8 wf[8][2];
#pragma unroll
    for (int h = 0; h < 2; ++h) {
        float v[4][2][8];
#pragma unroll
        for (int s = 0; s < 4; ++s)
#pragma unroll
            for (int nb = 0; nb < 2; ++nb) { const float* wp = w_in + (size_t)(128 * w + 16 * (4 * h + s) + 8 * hi) * 2368 + 768 + rope_orig(32 * nb + r32);
#pragma unroll
                for (int j = 0; j < 8; ++j) v[s][nb][j] = wp[(size_t)j * 2368]; }
        asm volatile("" ::: "memory");
#pragma unroll
        for (int s = 0; s < 4; ++s)
#pragma unroll
            for (int nb = 0; nb < 2; ++nb) { v4u o; o.x = pk2(v[s][nb][0], v[s][nb][1]); o.y = pk2(v[s][nb][2], v[s][nb][3]); o.z = pk2(v[s][nb][4], v[s][nb][5]); o.w = pk2(v[s][nb][6], v[s][nb][7]); wf[4 * h + s][nb] = __builtin_bit_cast(bf16x8, o); }
    }
    mid();
    LAS unsigned char* stage = F.lds + RING_OFF + w * P0_WAVE; LAS unsigned char* part = F.lds + RING_OFF + P0_PART;
    float fqv[4];
#pragma unroll
    for (int i = 0; i < 4; ++i) fqv[i] = pg8::rope_inv_freq(16 * ((F.tid & 7) >> 2) + 4 * (F.tid & 3) + i);
    const int nq = F.vcu < M / 32 ? (M / 32 - 1 - F.vcu) / F.G + 1 : 0;
    int pvn = nq ? pos[(size_t)F.vcu * 32 + ((F.tid >> 3) & 31)] : 0;
    auto iter = [&](const int q, auto LAST) {
        const size_t R0 = (size_t)(F.vcu + q * F.G) * 32;
        const int pv = pvn;
        v4u o[8];
#pragma unroll
        for (int i = 0; i < 8; ++i) o[i] = pg8::pack8f(cur[2 * i], cur[2 * i + 1]);
        if constexpr (!decltype(LAST)::value) { const size_t R1 = (size_t)(F.vcu + (q + 1) * F.G) * 32;
            pvn = pos[R1 + ((F.tid >> 3) & 31)];
            P0_XLOADS(R1); }
#pragma unroll
        for (int i = 0; i < 8; ++i) { *(v4u*)P0_XB(R0, i) = o[i]; *(LAS v4u*)(stage + P0_ROW(i) * P0_SP + P0_COL(i) * 2) = o[i]; }
        bf16x8 xf[8];
#pragma unroll
        for (int s = 0; s < 8; ++s) xf[s] = *(const LAS bf16x8*)(stage + r32 * P0_SP + s * 32 + hi * 16);
        f32x16_p0 a0 = {}, a1 = {};
#pragma unroll
        for (int s = 0; s < 8; ++s) { a0 = __builtin_amdgcn_mfma_f32_32x32x16_bf16(wf[s][0], xf[s], a0, 0, 0, 0); a1 = __builtin_amdgcn_mfma_f32_32x32x16_bf16(wf[s][1], xf[s], a1, 0, 0, 0); }
        if (q > 0) __syncthreads();
#pragma unroll
        for (int g = 0; g < 4; ++g) { LAS unsigned char* pp = part + w * P0_WAVE + r32 * P0_SP + 32 * g + 16 * hi;
            *(LAS f32x4*)pp = (f32x4){a0[4 * g], a0[4 * g + 1], a0[4 * g + 2], a0[4 * g + 3]}; *(LAS f32x4*)(pp + 128) = (f32x4){a1[4 * g], a1[4 * g + 1], a1[4 * g + 2], a1[4 * g + 3]}; }
        __syncthreads();
        if (F.tid < 256) { const int tok = F.tid >> 3, c = F.tid & 7; const size_t row = R0 + tok;
            f32x4 pa[8][2];
#pragma unroll
            for (int ww = 0; ww < 8; ++ww) { const LAS f32x4* pp = (const LAS f32x4*)(part + ww * P0_WAVE + tok * P0_SP + c * 32); pa[ww][0] = pp[0]; pa[ww][1] = pp[1]; }
            const f32x4 t1 = ((pa[0][0] + pa[1][0]) + (pa[2][0] + pa[3][0])) + ((pa[4][0] + pa[5][0]) + (pa[6][0] + pa[7][0]));
            const f32x4 t2 = ((pa[0][1] + pa[1][1]) + (pa[2][1] + pa[3][1])) + ((pa[4][1] + pa[5][1]) + (pa[6][1] + pa[7][1]));
            const float pf = (float)pv; f32x4 o1, o2;
#pragma unroll
            for (int i = 0; i < 4; ++i) { float sn, cs; pg8::sincos_rad(pf * fqv[i], sn, cs); o1[i] = t1[i] * cs - t2[i] * sn; o2[i] = t1[i] * sn + t2[i] * cs; }
            __builtin_nontemporal_store(pg8::pack8f(o1, o2), (pg8::u32x4*)(KR + row * 64 + 8 * c)); }
    };
#pragma unroll 1
    for (int q = 0; q + 1 < nq; ++q) iter(q, P0False{});
    if (nq) iter(nq - 1, P0True{});
}
#endif
__device__ __forceinline__ void p0_prologue(const Frame& F, const Args& a) {
    const float* x = (const float*)a.in[0]; const int* pos = (const int*)a.in[1]; const float* w_in = (const float*)a.in[2]; const float* qg = (const float*)a.in[3];
    const float* w_uq = (const float*)a.in[4]; const float* kvg = (const float*)a.in[5]; const float* w_ukv = (const float*)a.in[6]; const float* pool_w = (const float*)a.in[7];
    const float* pool_scale = (const float*)a.in[8]; const float* w_out = (const float*)a.in[9];
    unsigned char* ws = a.ws;
    const size_t gt = (size_t)F.vcu * 512 + F.tid, NTH = (size_t)F.G * 512;
#ifndef ROPE_P0
#ifdef PROBE_P0X2
    for (int rep_ = 0; rep_ < 2; ++rep_)
#endif
    { const f32x4* x4 = (const f32x4*)x; v4u* xb = (v4u*)(ws + WS_XB);
      for (size_t i = gt; i < (size_t)M * D / 8; i += NTH) { const f32x4 p = P0_LD(x4 + 2 * i), q = P0_LD(x4 + 2 * i + 1); v4u o; o.x = pk2(p[0], p[1]); o.y = pk2(p[2], p[3]); o.z = pk2(q[0], q[1]); o.w = pk2(q[2], q[3]);
#ifdef TILE_XB
          { const size_t row = i >> 7; const int col = (int)(i & 127) * 8;
            *(v4u*)((char*)xb + ((row >> 4) * 32 + (size_t)(col >> 5)) * 1024 + (row & 15) * 64 + (size_t)(col & 31) * 2) = o; }
#else
          xb[i] = o;
#endif
      } }
#endif
#ifdef LN_POLL
    { v4u* st = (v4u*)(ws + WS_STAT); const v4u z = {0u, 0u, 0u, 0u};
      for (size_t i = gt; i < (size_t)M * 16 * 8 / 16; i += NTH) st[i] = z; }
#endif
    auto rest = [&]() {
    { bf16* wt = (bf16*)(ws + WS_WIN);
      for (size_t idx = gt; idx < (size_t)NIN * 128; idx += NTH) { const int n = (int)((idx >> 6) % (NIN / 8)) * 8 + (int)(idx & 7), kc = (int)((idx >> 6) / (NIN / 8)) * 8 + (int)((idx >> 3) & 7);
          int src; if (n < 768) src = n; else if (n < 2304) src = n + 64; else { const int p = n - 2304; src = p < 64 ? 768 + rope_orig(p) : -1; }
          float v[8];
#pragma unroll
          for (int j = 0; j < 8; ++j) v[j] = src >= 0 ? w_in[(size_t)(8 * kc + j) * 2368 + src] : 0.f;
          v4u o; o.x = pk2(v[0], v[1]); o.y = pk2(v[2], v[3]); o.z = pk2(v[4], v[5]); o.w = pk2(v[6], v[7]); *(v4u*)(wt + (size_t)n * 1024 + 8 * kc) = o; } }
    { bf16* wt = (bf16*)(ws + WS_WUQ);
      for (size_t idx = gt; idx < (size_t)768 * 64; idx += NTH) { const int c = (int)((idx >> 6) % (768 / 8)) * 8 + (int)(idx & 7), kc = (int)((idx >> 6) / (768 / 8)) * 8 + (int)((idx >> 3) & 7);
          int src; if (c < 512) src = (c >> 7) * 192 + (c & 127); else { const int cc = c - 512; src = (cc >> 6) * 192 + 128 + rope_orig(cc & 63); }
          float v[8];
#pragma unroll
          for (int j = 0; j < 8; ++j) v[j] = qg[8 * kc + j] * w_uq[(size_t)(8 * kc + j) * 768 + src];
          v4u o; o.x = pk2(v[0], v[1]); o.y = pk2(v[2], v[3]); o.z = pk2(v[4], v[5]); o.w = pk2(v[6], v[7]); *(v4u*)(wt + (size_t)c * 512 + 8 * kc) = o; } }
    { bf16* wt = (bf16*)(ws + WS_WUKV);
      for (size_t idx = gt; idx < (size_t)1024 * 32; idx += NTH) { const int c = (int)((idx >> 6) % (1024 / 8)) * 8 + (int)(idx & 7), kc = (int)((idx >> 6) / (1024 / 8)) * 8 + (int)((idx >> 3) & 7);
          float v[8];
#pragma unroll
          for (int j = 0; j < 8; ++j) v[j] = kvg[8 * kc + j] * w_ukv[(size_t)(8 * kc + j) * 1024 + c];
          v4u o; o.x = pk2(v[0], v[1]); o.y = pk2(v[2], v[3]); o.z = pk2(v[4], v[5]); o.w = pk2(v[6], v[7]); *(v4u*)(wt + (size_t)c * 256 + 8 * kc) = o; } }
    { bf16* wt = (bf16*)(ws + WS_PW);
      for (size_t idx = gt; idx < (size_t)512 * 16; idx += NTH) { const int gd = (int)((idx >> 6) % (512 / 8)) * 8 + (int)(idx & 7), kc = (int)((idx >> 6) / (512 / 8)) * 8 + (int)((idx >> 3) & 7), g = gd >> 7, d = gd & 127; const float sc = pool_scale[gd];
          float v[8];
#pragma unroll
          for (int j = 0; j < 8; ++j) v[j] = sc * pool_w[((size_t)g * 128 + 8 * kc + j) * 128 + d];
          v4u o; o.x = pk2(v[0], v[1]); o.y = pk2(v[2], v[3]); o.z = pk2(v[4], v[5]); o.w = pk2(v[6], v[7]); *(v4u*)(wt + (size_t)gd * 128 + 8 * kc) = o; } }
    { bf16* wt = (bf16*)(ws + WS_WOUT);
      for (size_t idx = gt; idx < (size_t)1024 * 128; idx += NTH) { const int c = (int)((idx >> 6) % (1024 / 8)) * 8 + (int)(idx & 7), kc = (int)((idx >> 6) / (1024 / 8)) * 8 + (int)((idx >> 3) & 7);
          float v[8];
#pragma unroll
          for (int j = 0; j < 8; ++j) v[j] = w_out[(size_t)(8 * kc + j) * 1024 + c] * (1.0f / ALPHA);
          v4u o; o.x = pk2(v[0], v[1]); o.y = pk2(v[2], v[3]); o.z = pk2(v[4], v[5]); o.w = pk2(v[6], v[7]); *(v4u*)(wt + (size_t)c * 1024 + 8 * kc) = o; } }
    { int* pmin = (int*)(ws + WS_POSMM); int* pmax = pmin + 1024; int* hmin = pmin + 2048;
      for (int it = F.vcu * NWAVES + F.wave; it < BATCH * 32; it += F.G * NWAVES) { const int v = pos[(size_t)it * 64 + F.lane]; int mn = v, mx = v;
#pragma unroll
          for (int o = 1; o < 32; o <<= 1) { mn = min(mn, __shfl_xor(mn, o)); mx = max(mx, __shfl_xor(mx, o)); }
          const int mno = __shfl_xor(mn, 32), mxo = __shfl_xor(mx, 32);
          if (F.lane == 0) { pmin[it] = min(mn, mno); pmax[it] = max(mx, mxo); hmin[2 * it] = mn; hmin[2 * it + 1] = mno; } } }
    };
#ifdef ROPE_P0
    p0_x_rope(F, x, w_in, pos, (bf16*)(ws + WS_XB), (bf16*)(ws + WS_KR), rest);
#ifdef PROBE_P0X2
    __syncthreads(); p0_x_rope(F, x, w_in, pos, (bf16*)(ws + WS_XB), (bf16*)(ws + WS_KR), [](){});
#endif
#else
    rest();
#endif
}

__global__ void __launch_bounds__(NWAVES * 64, 2) mk_fwd(Args args) {
    extern __shared__ __attribute__((aligned(16))) unsigned char lds[];
    Frame F;
    F.lds = (LAS unsigned char*)lds;
    F.MISC = (volatile LAS unsigned*)(F.lds + MISC_OFF);
    F.tid = threadIdx.x; F.lane = F.tid & 63; F.wave = __builtin_amdgcn_readfirstlane(F.tid >> 6);
    F.G = gridDim.x; { const int bx = blockIdx.x; F.vcu = (F.G % 8 == 0) ? (bx % 8) * (F.G / 8) + bx / 8 : bx; }
#ifdef PROBE_BARX
#define PROBE_BAR_EXTRA xcd_barrier(bar); xcd_barrier(bar); xcd_barrier(bar); xcd_barrier(bar);
#else
#define PROBE_BAR_EXTRA
#endif
#define GRID_BAR(seam) do { if (N_LAUNCHES == PER_PHASE) { if (F.tid == 0) __hip_atomic_store(F.ctl + CW_TMO, 0xBADBA0u | (unsigned)(seam), RLX_AGENT); } \
    else { xcd_barrier(bar); PROBE_BAR_EXTRA } } while (0)
#if defined(GROUP_BAR) && defined(LN_L2SCOPE)
#define L2SCOPE_FLAG (fastbar ? 1 : 0)
#else
#define L2SCOPE_FLAG 0
#endif
#ifdef GROUP_BAR
#define GROUP_SEAM_BAR(seam) do { if (fastbar) xcd_local_barrier(bar, (unsigned*)(F.ctl + CW_LBAR) + args.li * 2048); else GRID_BAR(seam); } while (0)
#else
#define GROUP_SEAM_BAR(seam) GRID_BAR(seam)
#endif
    unsigned char* ws = args.ws;
    F.ctl = (gu32*)(ws + WS_CTL);
    for (int u = F.tid; u < (LDS_BYTES - LDSCTL_OFF) / 4; u += NWAVES * 64) ((LAS unsigned*)(F.lds + LDSCTL_OFF))[u] = 0u;
    __syncthreads();
    XcdBarrier bar; bar.bar = (unsigned*)(F.ctl + CW_BAR) + args.li * XCD_BAR_WORDS; bar.x = 0; bar.st = nullptr;
    if (N_LAUNCHES != PER_PHASE) bar = xcd_barrier_post((unsigned*)(F.ctl + CW_BAR) + args.li * XCD_BAR_WORDS, F.MISC + 8);
#ifdef GROUP_BAR
    if (N_LAUNCHES != PER_PHASE && F.tid == 0) __hip_atomic_store(F.ctl + CW_XCC + (int)blockIdx.x, bar.x + 1u, __ATOMIC_RELAXED, __HIP_MEMORY_SCOPE_AGENT);
    bool fastbar = false;
#endif
    const int lo = args.ph_lo, hi = args.ph_hi;
#ifndef PH_MASK
#define PH_MASK 31
#endif
#define IN(k) (((PH_MASK >> (k)) & 1) && lo <= (k) && (k) < hi)
#define BOTH(k) (IN(k) && IN((k) + 1))
    typedef pg8::bf16_t b16;
    b16* XB = (b16*)(ws + WS_XB); b16* Y = (b16*)(ws + WS_Y); b16* XQ = (b16*)(ws + WS_XQ); b16* XKV = (b16*)(ws + WS_XKV); b16* KR = (b16*)(ws + WS_KR);
    b16* GA = (b16*)(ws + WS_GA); b16* U = (b16*)(ws + WS_U); b16* GB = (b16*)(ws + WS_GB); b16* Q = (b16*)(ws + WS_Q); b16* KN = (b16*)(ws + WS_KN); b16* VV = (b16*)(ws + WS_VV);
    float* SSQ = (float*)(ws + WS_SSQ);
    const int* pos = (const int*)args.in[1];
    const int* pmin = (const int*)(ws + WS_POSMM); const int* pmax = pmin + 1024; const int* hmin = pmin + 2048;

    if (IN(0)) { p0_prologue(F, args); if (BOTH(0)) GRID_BAR(0); }
#if defined(GROUP_BAR) && !defined(PROBE_PHASE)
    if (N_LAUNCHES == 1 && BOTH(0) && F.G == 256) { int okv = 1;
        if (F.tid < 256) { const unsigned a = __hip_atomic_load(F.ctl + CW_XCC + F.tid, __ATOMIC_RELAXED, __HIP_MEMORY_SCOPE_AGENT), r = __hip_atomic_load(F.ctl + CW_XCC + (F.tid & 7), __ATOMIC_RELAXED, __HIP_MEMORY_SCOPE_AGENT);
            okv = (a != 0u) && (a == r);
            if (F.tid < 8) { for (int u = 0; u < 8; ++u) if (u != F.tid) okv = okv && (__hip_atomic_load(F.ctl + CW_XCC + u, __ATOMIC_RELAXED, __HIP_MEMORY_SCOPE_AGENT) != a); } }
        fastbar = __syncthreads_and(okv) != 0; }
#ifdef PROBE_NOFAST
    fastbar = false;
#endif
#endif

    if (IN(1)) {
#ifdef ATT_PRESTATS
        { const int item = F.vcu * NWAVES + F.wave, ab = item >> 6, aq = (item >> 3) & 7, aw = item & 7;
          if (item < BATCH * 64) { const int* pmx = pmax + ab * 32 + 4 * aq; const int qmax = max(max(pmx[0], pmx[1]), max(pmx[2], pmx[3]));
              const int pml = pmin[ab * 32 + (F.lane & 31)], pxl = pmax[ab * 32 + (F.lane & 31)];
              const unsigned m32 = (unsigned)__ballot(pml <= qmax); const int nt = m32 ? 32 - __clz(m32) : 1;
              const int qminw = hmin[ab * 64 + aq * 8 + aw]; const unsigned mb = (unsigned)__ballot(pxl > qminw);
              if (F.lane == 0) { int* ast = (int*)pmin + 4096 + item * 2; ast[0] = nt; ast[1] = (int)mb; } } }
#endif
#ifdef P1_GROUP_STAGGER_US
        { const unsigned long long t0 = __builtin_amdgcn_s_memrealtime(); const unsigned long long w = (unsigned long long)(P1_GROUP_STAGGER_US * 100) * (unsigned)((int)blockIdx.x & 7); while (__builtin_amdgcn_s_memrealtime() - t0 < w) __builtin_amdgcn_s_sleep(8); }
#endif
#ifdef P1_DELAY_US
        if (((int)blockIdx.x >> 3) & 1) { const unsigned long long t0 = __builtin_amdgcn_s_memrealtime(); while (__builtin_amdgcn_s_memrealtime() - t0 < (unsigned long long)(P1_DELAY_US * 100)) __builtin_amdgcn_s_sleep(8); }
#endif
        pg8::Gemm g{XB, (const b16*)(ws + WS_WIN), M, NIN, D, TILE_XB_FLAG}; P1_ORDER S; S.init(M, NIN, F.G, (int)blockIdx.x);
        pg8::EpiP1 E{XQ, XKV, GA, U, GB, KR, SSQ, (LAS float*)(F.lds + RSTAT_OFF), pos};
        pg8::gemm_phase<pg8::EpiP1, P1_ORDER, PG8_ALIGN, PG8_SP2>(F.lds + RING_OFF, g, S, E);
        if (BOTH(1)) GROUP_SEAM_BAR(1);
    }

    if (IN(2)) {
#ifdef P2_DELAY_US
        if (((int)blockIdx.x >> 3) & 1) { const unsigned long long t0 = __builtin_amdgcn_s_memrealtime(); while (__builtin_amdgcn_s_memrealtime() - t0 < (unsigned long long)(P2_DELAY_US * 100)) __builtin_amdgcn_s_sleep(8); }
#endif
#ifdef GROUP_BAR
#define POOL_PM(L, i) (32 * (F.vcu >> 5) + ((F.vcu & 31) >> 2) + 8 * (i))
#else
#define POOL_PM(L, i) P2_PM((L) >> 2)
#endif
#define P2_POOL() do { const pool::Tensors PT{U, GB, (const b16*)(ws + WS_PW), Y}; int i = 0; \
            for (int L = F.vcu; L < (M / 256) * 4; L += F.G, ++i) { const int Ln = L + F.G; \
                pool::pool_unit(POOL_PM(L, i), ((L & 3) + i) & 3, PT, (pool::lptr)(F.lds + RING_OFF), Ln < (M / 256) * 4 ? POOL_PM(Ln, i + 1) : -1, ((Ln & 3) + i + 1) & 3); } \
            __syncthreads(); } while (0)
#define P2_GEMM_Q() do { pg8::Gemm g{XQ, (const b16*)(ws + WS_WUQ), M, 768, 512, TILE_XQKV}; P2_ORDER S; S.init(M, 768, F.G, (int)blockIdx.x); pg8::EpiQ E{Q, pos}; \
              pg8::gemm_phase<pg8::EpiQ, P2_ORDER, PG8_ALIGN, PG8_SP2>(F.lds + RING_OFF, g, S, E); } while (0)
#define P2_GEMM_KV() do { pg8::Gemm g{XKV, (const b16*)(ws + WS_WUKV), M, 1024, 256, TILE_XQKV}; P2_ORDER S; S.init(M, 1024, F.G, (int)blockIdx.x); pg8::EpiKV E{KN, VV}; \
              pg8::gemm_phase<pg8::EpiKV, P2_ORDER, PG8_ALIGN, PG8_SP2>(F.lds + RING_OFF, g, S, E); } while (0)
#define P2_GEMMS() do { \
            { pg8::Gemm g{XQ, (const b16*)(ws + WS_WUQ), M, 768, 512, TILE_XQKV}; P2_ORDER S; S.init(M, 768, F.G, (int)blockIdx.x); \
              pg8::EpiQ E{Q, pos}; \
              pg8::gemm_phase<pg8::EpiQ, P2_ORDER, PG8_ALIGN, PG8_SP2>(F.lds + RING_OFF, g, S, E); } \
            { pg8::Gemm g{XKV, (const b16*)(ws + WS_WUKV), M, 1024, 256, TILE_XQKV}; P2_ORDER S; S.init(M, 1024, F.G, (int)blockIdx.x); \
              pg8::EpiKV E{KN, VV}; \
              pg8::gemm_phase<pg8::EpiKV, P2_ORDER, PG8_ALIGN, PG8_SP2>(F.lds + RING_OFF, g, S, E); } } while (0)
#if defined(P2_REP_POOL)
        P2_POOL(); P2_POOL(); P2_GEMMS();
#elif defined(P2_REP_GEMMS)
        P2_GEMMS(); P2_GEMMS(); P2_POOL();
#elif defined(P2_REP_Q)
        P2_GEMM_Q(); P2_GEMMS(); P2_POOL();
#elif defined(P2_REP_KV)
        P2_GEMM_KV(); P2_GEMMS(); P2_POOL();
#elif defined(P2_SWAP_ODD)
        { const int odd = ((int)blockIdx.x >> 3) & 1;
#pragma unroll 1
          for (int t = 0; t < 2; ++t) { if ((t ^ odd) == 0) P2_GEMM_Q(); else P2_GEMM_KV(); } }
        P2_POOL();
#elif defined(P2_KV_FIRST)
        P2_GEMM_KV(); P2_GEMM_Q(); P2_POOL();
#elif defined(P2_KV_LAST)
        P2_GEMM_Q(); P2_POOL(); P2_GEMM_KV();
#elif defined(P2_POOL_FIRST)
        P2_POOL(); P2_GEMMS();
#elif defined(P2_SEQ)
        P2_GEMMS(); P2_POOL();
#elif defined(POOL_IN_P3) || defined(FUSE34_POOL)
        P2_GEMMS();
#else
        P2_GEMMS(); P2_POOL();
#endif
#undef P2_POOL
#undef P2_GEMMS
        if (BOTH(2)) GROUP_SEAM_BAR(2);
    }

#ifdef FUSE34
    if (IN(3)) {
        const attn::Tensors AT{Q, KN, KR, VV, GA, Y, SSQ, pos, pmin, pmax, hmin, L2SCOPE_FLAG, pmin + 4096};
        gu32* pcnt = F.ctl + CW_PANEL + args.li * 256 * 16;
        const int it = F.vcu, bh = it >> 1, bb = bh >> 2, hh = bh & 3;
        const pg8::Gemm g{Y, (const b16*)(ws + WS_WOUT), M, D, D, TILE_Y_FLAG};
        const pg8::EpiOutLnPeer E{(const float*)args.in[0], args.out, (const float*)args.in[10], (const float*)args.in[11], (float*)(ws + WS_STAT), (unsigned*)(F.ctl + CW_SEAM) + args.li * 256 * 64, (unsigned*)(F.ctl + CW_TMO), F.lds + RSTAT_OFF, &bar, (unsigned*)pcnt, L2SCOPE_FLAG};
#ifndef QCYC_A
#define QCYC_A 0x1670
#define QCYC_B 0x4532
#endif
#ifndef QVROT
#define QVROT (bb & 3)
#endif
        const int qcyc = (it & 1) ? QCYC_B : QCYC_A, vrot = QVROT;
#ifdef FUSE34_LAG
#pragma unroll 1
        for (int k = 0; k < 5; ++k) {
            if (k < 4) { const int qb = (qcyc >> (4 * ((k + vrot) & 3))) & 15;
                attn::attn_unit(bb, hh, qb, AT, (attn::lptr)(F.lds + RING_OFF));
                if (F.tid == 0) (void)__hip_atomic_fetch_add(pcnt + (8 * bb + qb) * 16, 1u, __ATOMIC_RELAXED, __HIP_MEMORY_SCOPE_AGENT); }
            if (k >= 1) { const int qp = (qcyc >> (4 * ((k - 1 + vrot) & 3))) & 15, pm = 8 * bb + qp;
                if (F.tid == 0) { unsigned sp = 0u;
                    while (__hip_atomic_load(pcnt + pm * 16, __ATOMIC_RELAXED, __HIP_MEMORY_SCOPE_AGENT) < 4u) { __builtin_amdgcn_s_sleep(2);
                        if ((++sp & 1023u) == 0u && (sp > (1u << 22) || __hip_atomic_load(F.ctl + CW_TMO, __ATOMIC_RELAXED, __HIP_MEMORY_SCOPE_AGENT) != 0u)) { __hip_atomic_store(F.ctl + CW_TMO, 1u, __ATOMIC_RELAXED, __HIP_MEMORY_SCOPE_AGENT); break; } } }
                __syncthreads();
                pg8::OneOrder S; S.init(pm, hh);
                pg8::gemm_phase<pg8::EpiOutLnPeer, pg8::OneOrder, true, PG8_SP2>(F.lds + RING_OFF, g, S, E); __syncthreads(); } }
    }
#else
#pragma unroll 1
        for (int k = 0; k < 4; ++k) { int hq = hh, bq = bb; asm volatile("" : "+s"(hq), "+s"(bq));
            const int qb = (qcyc >> (4 * ((k + vrot) & 3))) & 15, pm = 8 * bq + qb;
#ifdef FUSE34_RELOAD
            unsigned char* wq = ws; asm volatile("" : "+s"(wq));
            const attn::Tensors AT{(const b16*)(wq + WS_Q), (const b16*)(wq + WS_KN), (const b16*)(wq + WS_KR), (const b16*)(wq + WS_VV), (const b16*)(wq + WS_GA), (b16*)(wq + WS_Y), (const float*)(wq + WS_SSQ), pos,
                                   (const int*)(wq + WS_POSMM), (const int*)(wq + WS_POSMM) + 1024, (const int*)(wq + WS_POSMM) + 2048};
            const pg8::Gemm g{(const b16*)(wq + WS_Y), (const b16*)(wq + WS_WOUT), M, D, D, TILE_Y_FLAG};
            const pg8::EpiOutLnPeer E{(const float*)args.in[0], args.out, (const float*)args.in[10], (const float*)args.in[11], (float*)(wq + WS_STAT), (unsigned*)(wq + WS_CTL + (size_t)(CW_SEAM + args.li * 256 * 64) * 4), (unsigned*)(wq + WS_CTL + (size_t)CW_TMO * 4), F.lds + RSTAT_OFF, &bar, (unsigned*)(wq + WS_CTL + (size_t)(CW_PANEL + args.li * 256 * 16) * 4), L2SCOPE_FLAG};
#endif
#ifdef FUSE34_POOL
            { unsigned char* wl = ws; asm volatile("" : "+s"(wl));
              const pool::Tensors PT{(const b16*)(wl + WS_U), (const b16*)(wl + WS_GB), (const b16*)(wl + WS_PW), (b16*)(wl + WS_Y)}; pool::pool_unit(pm, hq, PT, (pool::lptr)(F.lds + RING_OFF));
              asm volatile("s_waitcnt vmcnt(0)" ::: "memory"); __syncthreads();
              if (F.tid == 0) (void)__hip_atomic_fetch_add(pcnt + pm * 16 + 1, 1u, __ATOMIC_RELAXED, __HIP_MEMORY_SCOPE_AGENT); }
#endif
#ifdef PROBE_ATTN2
            attn::attn_unit(bq, hq, qb, AT, (attn::lptr)(F.lds + RING_OFF));
#endif
            attn::attn_unit(bq, hq, qb, AT, (attn::lptr)(F.lds + RING_OFF));
#ifdef FUSE34_POOL
            if (F.tid == 0) { unsigned sp = 0u;
                while (__hip_atomic_load(pcnt + pm * 16 + 1, __ATOMIC_RELAXED, __HIP_MEMORY_SCOPE_AGENT) < 4u) { __builtin_amdgcn_s_sleep(2);
                    if ((++sp & 1023u) == 0u && (sp > (1u << 22) || __hip_atomic_load(F.ctl + CW_TMO, __ATOMIC_RELAXED, __HIP_MEMORY_SCOPE_AGENT) != 0u)) { __hip_atomic_store(F.ctl + CW_TMO, 1u, __ATOMIC_RELAXED, __HIP_MEMORY_SCOPE_AGENT); break; } } }
            __syncthreads();
#endif
#ifndef FUSE34_KROT
            if (F.tid == 0) { (void)__hip_atomic_fetch_add(pcnt + pm * 16, 1u, __ATOMIC_RELAXED, __HIP_MEMORY_SCOPE_AGENT); unsigned sp = 0u;
                while (__hip_atomic_load(pcnt + pm * 16, __ATOMIC_RELAXED, __HIP_MEMORY_SCOPE_AGENT) < 4u) { __builtin_amdgcn_s_sleep(2);
                    if ((++sp & 1023u) == 0u && (sp > (1u << 22) || __hip_atomic_load(F.ctl + CW_TMO, __ATOMIC_RELAXED, __HIP_MEMORY_SCOPE_AGENT) != 0u)) { __hip_atomic_store(F.ctl + CW_TMO, 1u, __ATOMIC_RELAXED, __HIP_MEMORY_SCOPE_AGENT); break; } } }
            __syncthreads();
#endif
#ifdef PROBE_P4K2
            _Pragma("unroll 1") for (int rep_ = 1; rep_ >= 0; --rep_) { pg8::OneOrder S; S.init(pm, hq, rep_);
            pg8::gemm_phase<pg8::EpiOutLnPeer, pg8::OneOrder, true, PG8_SP2>(F.lds + RING_OFF, g, S, E); __syncthreads(); } }
#else
            pg8::OneOrder S; S.init(pm, hq);
            pg8::gemm_phase<pg8::EpiOutLnPeer, pg8::OneOrder, true, PG8_SP2>(F.lds + RING_OFF, g, S, E); __syncthreads(); }
#endif
    }
#endif
#else
    if (IN(3)) {
        const attn::Tensors AT{Q, KN, KR, VV, GA, Y, SSQ, pos, pmin, pmax, hmin};
#ifdef POOL_IN_P3
        const pool::Tensors PT{U, GB, (const b16*)(ws + WS_PW), Y};
        { const int it = F.vcu, bh = it >> 1, s = 2 * (it & 1), rot = (it & 1) ? 4 : 0;
#pragma unroll 1
          for (int kk = 0; kk < 8; ++kk) { const int k = (kk + rot) & 7;
              if (k < 4) { const int qb = (k == 0) ? s : (k == 1) ? 7 - s : (k == 2) ? s + 1 : 6 - s; attn::attn_unit(bh >> 2, bh & 3, qb, AT, (attn::lptr)(F.lds + RING_OFF)); }
              else { const int i = k - 4, L = F.vcu + i * F.G; pool::pool_unit(L >> 2, ((L & 3) + i) & 3, PT, (pool::lptr)(F.lds + RING_OFF)); __syncthreads(); } } }
#else
        for (int it = F.vcu; it < BATCH * 4 * 2; it += F.G) { const int bh = it >> 1, s = 2 * (it & 1);
#pragma unroll 1
            for (int k = 0; k < 4; ++k) { const int qb = (k == 0) ? s : (k == 1) ? 7 - s : (k == 2) ? s + 1 : 6 - s;
                attn::attn_unit(bh >> 2, bh & 3, qb, AT, (attn::lptr)(F.lds + RING_OFF)); } }
#endif
        if (BOTH(3)) GRID_BAR(3);
    }

    if (IN(4)) {
#ifdef P4_STAGGER_US
        if (((int)blockIdx.x & 7) >= 4) { const unsigned long long t0 = __builtin_amdgcn_s_memrealtime(); while (__builtin_amdgcn_s_memrealtime() - t0 < (unsigned long long)(P4_STAGGER_US * 100)) __builtin_amdgcn_s_sleep(8); }
#endif
#ifdef PROBE_KLOOP2
        const pg8::Gemm g{Y, (const b16*)(ws + WS_WOUT), M, D, D}; pg8::DupOrder S; S.init(M, D, F.G, (int)blockIdx.x);
#define P4_ORDER pg8::DupOrder
#elif defined(P4_AB)
#ifdef P4_AB_DELAY_US
        if (((int)blockIdx.x >> 3) & 1) { const unsigned long long t0 = __builtin_amdgcn_s_memrealtime(); while (__builtin_amdgcn_s_memrealtime() - t0 < (unsigned long long)(P4_AB_DELAY_US * 100)) __builtin_amdgcn_s_sleep(8); }
#endif
        const pg8::Gemm g{Y, (const b16*)(ws + WS_WOUT), M, D, D}; pg8::AbOrder S; S.init(M, D, F.G, (int)blockIdx.x);
#define P4_ORDER pg8::AbOrder
#else
        const pg8::Gemm g{Y, (const b16*)(ws + WS_WOUT), M, D, D}; pg8::StaticOrder S; S.init(M, D, F.G, (int)blockIdx.x);
#define P4_ORDER pg8::StaticOrder
#endif
        const pg8::EpiOutLnPeer E{(const float*)args.in[0], args.out, (const float*)args.in[10], (const float*)args.in[11], (float*)(ws + WS_STAT), (unsigned*)(F.ctl + CW_SEAM) + args.li * 256 * 64, (unsigned*)(F.ctl + CW_TMO), F.lds + RSTAT_OFF, &bar};
        pg8::gemm_phase<pg8::EpiOutLnPeer, P4_ORDER, true, PG8_SP2>(F.lds + RING_OFF, g, S, E);
    }
#endif
#undef IN
#undef BOTH
}


#ifdef DBG_SEL
__device__ __forceinline__ float dbg_b2f(const unsigned short* p, size_t i) { return __uint_as_float(((unsigned)p[i]) << 16); }
__global__ void dbg_dump(unsigned char* ws, float* out, int sel) {
    const size_t n = (size_t)M * D;
    for (size_t i = blockIdx.x * (size_t)blockDim.x + threadIdx.x; i < n; i += (size_t)gridDim.x * blockDim.x) {
        float v = 0.f;
        if (sel == 1) { v = dbg_b2f((const unsigned short*)(ws + WS_XQ), i % ((size_t)M * 512)) + dbg_b2f((const unsigned short*)(ws + WS_XKV), i % ((size_t)M * 256)) + dbg_b2f((const unsigned short*)(ws + WS_GA), i % ((size_t)M * 512))
                        + dbg_b2f((const unsigned short*)(ws + WS_U), i % ((size_t)M * 512)) + dbg_b2f((const unsigned short*)(ws + WS_GB), i % ((size_t)M * 512)) + dbg_b2f((const unsigned short*)(ws + WS_KR), i % ((size_t)M * 64))
                        + ((const float*)(ws + WS_SSQ))[i % ((size_t)M * 8)] + ((const float*)(ws + WS_SSKV))[i % ((size_t)M * 4)]; }
        else if (sel == 2) { v = dbg_b2f((const unsigned short*)(ws + WS_Q), i % ((size_t)M * 768)) + dbg_b2f((const unsigned short*)(ws + WS_KN), i % ((size_t)M * 512)) + dbg_b2f((const unsigned short*)(ws + WS_VV), i % ((size_t)M * 512)); }
        else if (sel == 3) { const size_t r = i / 1024, c = i % 1024; v = c >= 512 ? dbg_b2f((const unsigned short*)(ws + WS_Y), r * 1024 + c) : 0.f; }
        else if (sel == 4) { const size_t r = i / 1024, c = i % 1024; v = c < 512 ? dbg_b2f((const unsigned short*)(ws + WS_Y), r * 1024 + c) : 0.f; }
        else if (sel == 5) { v = dbg_b2f((const unsigned short*)(ws + WS_WIN), i % ((size_t)NIN * 1024)) + dbg_b2f((const unsigned short*)(ws + WS_WUQ), i % ((size_t)768 * 512)) + dbg_b2f((const unsigned short*)(ws + WS_WUKV), i % ((size_t)1024 * 256))
                        + dbg_b2f((const unsigned short*)(ws + WS_PW), i % ((size_t)512 * 128)) + dbg_b2f((const unsigned short*)(ws + WS_WOUT), i % ((size_t)1024 * 1024)) + dbg_b2f((const unsigned short*)(ws + WS_XB), i) + (float)((const int*)(ws + WS_POSMM))[i % 4096]; }
        out[i] = v;
    }
}
#endif
extern "C" void kernel_launch(void* const* d_in, const int* in_sizes, int n_in, void* d_out, int out_size, void* d_ws, size_t ws_size, hipStream_t stream) {
    static int grid = 0;
    if (grid == 0) {
        if (n_in != 12 || in_sizes[0] != M * D || out_size != M * D || ws_size < WS_END) { fprintf(stderr, "kernel_launch: shape/workspace mismatch (n_in %d in0 %d out %d ws %zu, need ws >= %zu)\n", n_in, n_in > 0 ? in_sizes[0] : -1, out_size, ws_size, (size_t)WS_END); grid = -1; return; }
        int dev = 0, cus = 0, per_cu = 0;
        if (hipGetDevice(&dev) != hipSuccess || hipDeviceGetAttribute(&cus, hipDeviceAttributeMultiprocessorCount, dev) != hipSuccess) { fprintf(stderr, "kernel_launch: device query failed\n"); grid = -1; return; }
        if (hipFuncSetAttribute((const void*)mk_fwd, hipFuncAttributeMaxDynamicSharedMemorySize, LDS_BYTES) != hipSuccess) { fprintf(stderr, "kernel_launch: hipFuncSetAttribute failed\n"); grid = -1; return; }
        if (hipOccupancyMaxActiveBlocksPerMultiprocessor(&per_cu, (const void*)mk_fwd, NWAVES * 64, LDS_BYTES) != hipSuccess || per_cu < 1) fprintf(stderr, "kernel_launch: note: occupancy query reports %d workgroups per CU\n", per_cu);
        (void)hipGetLastError();
        grid = cus;
        if (grid != 256) fprintf(stderr, "kernel_launch: %d CUs; the fused LayerNorm phase needs 256\n", grid);
    }
    if (grid < 0) return;
    if (hipMemsetAsync((char*)d_ws + WS_CTL, 0, CTL_ZERO_BYTES, stream) != hipSuccess) { fprintf(stderr, "kernel_launch: hipMemsetAsync failed\n"); return; }
    Args a{};
    for (int i = 0; i < 12; ++i) a.in[i] = d_in[i];
    a.out = (float*)d_out; a.ws = (unsigned char*)d_ws;
#ifdef DBG_SEL
    for (int li = 0; li <= DBG_UPTO; ++li) { a.ph_lo = li; a.ph_hi = li + 1; a.li = li; hipLaunchKernelGGL(mk_fwd, dim3(grid), dim3(NWAVES * 64), LDS_BYTES, stream, a); }
    hipLaunchKernelGGL(dbg_dump, dim3(2048), dim3(256), 0, stream, (unsigned char*)d_ws, (float*)d_out, DBG_SEL);
    return;
#endif
#ifdef PROBE_PHASE
    a.ph_lo = 0; a.ph_hi = PROBE_PHASE + 1; a.li = 0; hipLaunchKernelGGL(mk_fwd, dim3(grid), dim3(NWAVES * 64), LDS_BYTES, stream, a);
    a.ph_lo = PROBE_PHASE; a.ph_hi = PER_PHASE; a.li = 1; hipLaunchKernelGGL(mk_fwd, dim3(grid), dim3(NWAVES * 64), LDS_BYTES, stream, a);
    return;
#endif
    for (int li = 0; li < N_LAUNCHES; ++li) {
        a.ph_lo = (N_LAUNCHES == PER_PHASE) ? li : 0; a.ph_hi = (N_LAUNCHES == PER_PHASE) ? li + 1 : PER_PHASE; a.li = li;
        hipLaunchKernelGGL(mk_fwd, dim3(grid), dim3(NWAVES * 64), LDS_BYTES, stream, a);
        const hipError_t le = hipPeekAtLastError();
        if (le != hipSuccess) { fprintf(stderr, "kernel_launch: launch %d failed: %s\n", li, hipGetErrorName(le)); break; }
    }
}
```
